# Optimizing an MI355X kernel written in HIP

```python
import jax, jax.numpy as jnp
from jax import lax
import numpy as np

D_MODEL = 1024
BATCH = 8
SEQ = 4096
DEPTH = 2

CHUNK = 64
Q_BLOCK = 2 * CHUNK
N_META = 16
N_MIXERS = 2
POOL_WINDOWS = (2, 4, 8, 16)
N_POOL_GROUPS = len(POOL_WINDOWS)
POOL_GROUP = D_MODEL // N_POOL_GROUPS
MAX_WINDOW = max(POOL_WINDOWS)
N_HEADS = 16
HEAD_DIM = D_MODEL // N_HEADS
D_FF = -(-8 * D_MODEL // (3 * 256)) * 256
N_POOL_LAYERS = (DEPTH + 1) // 2
N_FOX_LAYERS = DEPTH // 2
DN_ALPHA = (2.0 * DEPTH) ** 0.25
DN_BETA = (8.0 * DEPTH) ** -0.25
LN_EPS = 1e-5

kernel_name = "hybrid_pool_fox_deepnorm_meta"


def layer_norm(x, g, b):
    xf = x.astype(jnp.float32)
    mu = jnp.mean(xf, axis=-1, keepdims=True)
    var = jnp.mean(jnp.square(xf - mu), axis=-1, keepdims=True)
    y = (xf - mu) * lax.rsqrt(var + LN_EPS)
    return (y * g.astype(jnp.float32) + b.astype(jnp.float32)).astype(x.dtype)


def pool_mixer(x, w_grp, scale):
    B, L, D = x.shape
    xf = x.astype(jnp.float32)
    P = jnp.pad(jnp.cumsum(xf, axis=1), ((0, 0), (MAX_WINDOW, 0), (0, 0)))
    t1 = jnp.arange(1, L + 1, dtype=jnp.float32)
    groups = []
    for g, w in enumerate(POOL_WINDOWS):
        sl = slice(g * POOL_GROUP, (g + 1) * POOL_GROUP)
        win_sum = P[:, MAX_WINDOW:MAX_WINDOW + L, sl] - P[:, MAX_WINDOW - w:MAX_WINDOW - w + L, sl]
        cnt = jnp.minimum(t1, float(w))[None, :, None]
        groups.append(win_sum / cnt - xf[:, :, sl])
    y = jnp.stack(groups, axis=2).astype(x.dtype)
    y = jnp.einsum('blgc,gce->blge', y, w_grp).reshape(B, L, D)
    return y * scale


def fox_mixer(x, w_in, b_f, w_o):
    B, L, D = x.shape
    proj = jnp.einsum('bld,de->ble', x, w_in)
    q, k, v, f_logit = jnp.split(proj, [D, 2 * D, 3 * D], axis=-1)
    to_heads = lambda t: t.reshape(B, L, N_HEADS, HEAD_DIM).transpose(0, 2, 1, 3)
    q, k, v = to_heads(q), to_heads(k), to_heads(v)
    log_f = jax.nn.log_sigmoid((f_logit + b_f).astype(jnp.float32))
    c = jnp.cumsum(log_f, axis=1).transpose(0, 2, 1)
    Lp = -(-L // Q_BLOCK) * Q_BLOCK
    pad = Lp - L
    padl = lambda t: jnp.pad(t, ((0, 0), (0, 0), (0, pad), (0, 0)))
    q, k, v = padl(q), padl(k), padl(v)
    c = jnp.pad(c, ((0, 0), (0, 0), (0, pad)))
    scale = HEAD_DIM ** -0.5
    neg = jnp.finfo(jnp.float32).min
    outs = []
    for qb in range(Lp // Q_BLOCK):
        q0, q1 = qb * Q_BLOCK, (qb + 1) * Q_BLOCK
        s = jnp.einsum('bhqd,bhkd->bhqk', q[:, :, q0:q1], k[:, :, :q1],
                       preferred_element_type=jnp.float32) * scale
        s = s + c[:, :, q0:q1, None] - c[:, :, None, :q1]
        mask = jnp.arange(q0, q1)[:, None] >= jnp.arange(q1)[None, :]
        s = jnp.where(mask[None, None], s, neg)
        p = jax.nn.softmax(s, axis=-1).astype(v.dtype)
        outs.append(jnp.einsum('bhqk,bhkd->bhqd', p, v[:, :, :q1]))
    o = jnp.concatenate(outs, axis=2)[:, :, :L]
    o = o.transpose(0, 2, 1, 3).reshape(B, L, D)
    return jnp.einsum('bld,de->ble', o, w_o)


def swiglu(x, w_gate, w_up, w_down):
    hg = jnp.einsum('bld,df->blf', x, w_gate)
    hu = jnp.einsum('bld,df->blf', x, w_up)
    return jnp.einsum('blf,fd->bld', jax.nn.silu(hg) * hu, w_down)


def setup_inputs(seed: int = 0) -> dict:
    key = jax.random.key(seed)
    ks = jax.random.split(key, 16)
    nrm = lambda k, shp: jax.random.normal(k, shp, dtype=jnp.float32)
    D, H, C, F = D_MODEL, N_HEADS, POOL_GROUP, D_FF
    x = nrm(ks[0], (BATCH, SEQ, D))
    meta_tokens = nrm(ks[1], (N_META, D))
    pool_w = nrm(ks[2], (N_POOL_LAYERS, N_POOL_GROUPS, C, C)) * (C ** -0.5) * DN_BETA
    pool_scale = 1.0 + 0.02 * nrm(ks[3], (N_POOL_LAYERS, D))
    w_qk = nrm(ks[4], (N_FOX_LAYERS, D, 2 * D)) * (D ** -0.5)
    w_v = nrm(ks[5], (N_FOX_LAYERS, D, D)) * (D ** -0.5) * DN_BETA
    w_f = nrm(ks[6], (N_FOX_LAYERS, D, H)) * (D ** -0.5)
    fox_w_in = jnp.concatenate([w_qk, w_v, w_f], axis=-1)
    fox_b_f = 2.0 + 0.1 * nrm(ks[7], (N_FOX_LAYERS, H))
    fox_w_o = nrm(ks[8], (N_FOX_LAYERS, D, D)) * (D ** -0.5) * DN_BETA
    ffn_w_gate = nrm(ks[9], (DEPTH, D, F)) * (D ** -0.5) * DN_BETA
    ffn_w_up = nrm(ks[10], (DEPTH, D, F)) * (D ** -0.5) * DN_BETA
    ffn_w_down = nrm(ks[11], (DEPTH, F, D)) * (F ** -0.5) * DN_BETA
    ln_g = 1.0 + 0.02 * nrm(ks[12], (DEPTH, 2, D))
    ln_b = 0.02 * nrm(ks[13], (DEPTH, 2, D))
    return {"x": x, "meta_tokens": meta_tokens, "pool_w": pool_w, "pool_scale": pool_scale,
            "fox_w_in": fox_w_in, "fox_b_f": fox_b_f, "fox_w_o": fox_w_o,
            "ffn_w_gate": ffn_w_gate, "ffn_w_up": ffn_w_up, "ffn_w_down": ffn_w_down,
            "ln_g": ln_g, "ln_b": ln_b}


def reference(x, meta_tokens, pool_w, pool_scale, fox_w_in, fox_b_f, fox_w_o,
              ffn_w_gate, ffn_w_up, ffn_w_down, ln_g, ln_b):
    B = x.shape[0]
    meta = jnp.broadcast_to(meta_tokens[None].astype(x.dtype), (B, N_META, D_MODEL))
    h = jnp.concatenate([meta, x], axis=1)
    for i in range(DEPTH):
        j = i // N_MIXERS
        if i % N_MIXERS == 0:
            m = pool_mixer(h, pool_w[j], pool_scale[j])
        else:
            m = fox_mixer(h, fox_w_in[j], fox_b_f[j], fox_w_o[j])
        h = layer_norm(DN_ALPHA * h + m, ln_g[i, 0], ln_b[i, 0])
        f = swiglu(h, ffn_w_gate[i], ffn_w_up[i], ffn_w_down[i])
        h = layer_norm(DN_ALPHA * h + f, ln_g[i, 1], ln_b[i, 1])
    return h[:, N_META:]
```

```cpp
#include <hip/hip_runtime.h>
#include <hip/hip_cooperative_groups.h>
#include <cstdio>
#include <cstdint>
namespace cg = cooperative_groups;

#define LAS __attribute__((address_space(3)))
typedef unsigned short bf16_t;
typedef short bf16x8 __attribute__((ext_vector_type(8)));
typedef short s16x4 __attribute__((ext_vector_type(4)));
typedef float f32x4 __attribute__((ext_vector_type(4)));
typedef float f32x2 __attribute__((ext_vector_type(2)));
typedef float f32x16 __attribute__((ext_vector_type(16)));
typedef unsigned u32x4 __attribute__((ext_vector_type(4)));
typedef unsigned u32x2 __attribute__((ext_vector_type(2)));
typedef __bf16 bf16x2_t __attribute__((ext_vector_type(2)));

constexpr int BATCH = 8, SEQ = 4096, NMETA = 16, LSEQ = SEQ + NMETA;
constexpr int D = 1024, DFF = 2816, NH = 16, HD = 64;
constexpr int M = BATCH * LSEQ;
constexpr int MP = 33024;
constexpr int LPAD = 4352, PADF = 240;
constexpr int MA = BATCH * LPAD;
constexpr int NIN = 3328;
constexpr float ALPHA = 1.41421356237309515f;
constexpr float LN_EPS = 1e-5f;
constexpr float LOG2E = 1.4426950408889634f;
constexpr float QSCALE = 0.125f * LOG2E;
constexpr float NEGBIG = -1e30f;

constexpr size_t MiB = 1u << 20;
constexpr size_t WS_CTL = 0;
constexpr size_t WS_WPOOL = 1 * MiB, WS_WGU0 = 2 * MiB, WS_WD0 = 13 * MiB, WS_WIN = 19 * MiB, WS_WO = 26 * MiB, WS_WGU1 = 28 * MiB, WS_WD1 = 39 * MiB;
constexpr size_t WS_H = 48 * MiB;
constexpr size_t WS_HB = 177 * MiB;
constexpr size_t WS_ACT = 242 * MiB;
constexpr size_t WS_Q = 242 * MiB, WS_K = 310 * MiB, WS_V = 378 * MiB;
constexpr size_t WS_LF = 446 * MiB;
constexpr size_t WS_C2 = 449 * MiB;
constexpr size_t WS_END = 452 * MiB;
static_assert(WS_H + (size_t)MP * D * 4 <= WS_HB && WS_HB + (size_t)MP * D * 2 <= WS_ACT && WS_ACT + (size_t)MP * DFF * 2 <= WS_LF, "ws map");
static_assert(WS_Q + (size_t)MA * D * 2 <= WS_K && WS_K + (size_t)MA * D * 2 <= WS_V && WS_V + (size_t)MA * D * 2 <= WS_LF, "ws map 2");
static_assert(WS_V - WS_K == WS_K - WS_Q && WS_LF + (size_t)M * 16 * 4 <= WS_C2 && WS_C2 + (size_t)128 * LPAD * 4 <= WS_END, "ws map 3");

constexpr int LDS_BYTES = 135168;
constexpr int LDSCTL_OFF = 131072;


__device__ __forceinline__ int lane_id_asm() { int l; asm volatile("v_mbcnt_lo_u32_b32 %0, -1, 0\n\tv_mbcnt_hi_u32_b32 %0, -1, %0" : "=v"(l)); return l; }
__device__ __forceinline__ void grid_bar(unsigned* ctr, unsigned target, int wave) {
    asm volatile("s_waitcnt vmcnt(0)" ::: "memory");
    __syncthreads();
    if (wave == 0 && lane_id_asm() == 0) {
        __builtin_amdgcn_fence(__ATOMIC_RELEASE, "agent");
        asm volatile("s_waitcnt vmcnt(0)" ::: "memory");
        __hip_atomic_fetch_add(ctr, 1u, __ATOMIC_RELAXED, __HIP_MEMORY_SCOPE_AGENT);
        while (__hip_atomic_load(ctr, __ATOMIC_RELAXED, __HIP_MEMORY_SCOPE_AGENT) < target) __builtin_amdgcn_s_sleep(2);
        __builtin_amdgcn_fence(__ATOMIC_ACQUIRE, "agent");
        asm volatile("s_waitcnt vmcnt(0)" ::: "memory");
    }
    __syncthreads();
}

namespace pg8 {
constexpr int BM = 256, BK = 64, HALF = 128, HTB = HALF * BK * 2, NXCD = 8, WGM = 8;
__host__ __device__ __forceinline__ int lds_byte(int r, int c) { const int st = (r >> 4) * 2 + (c >> 5), rr = r & 15, cc = c & 31, ob = rr * 64 + cc * 2; return st * 1024 + (ob ^ (((ob >> 9) & 1) << 5)); }
__host__ __device__ __forceinline__ void stage_rc(int b, int& R, int& C) { const int st = b / 1024, sb = b % 1024, swz = sb ^ (((sb >> 9) & 1) << 5); R = (st >> 1) * 16 + swz / 64; C = (st & 1) * 32 + (swz % 64) / 2; }
__host__ __device__ __forceinline__ int perm32(int rho) { const int n = rho >> 4, i = rho & 15; return 8 * (i >> 2) + 4 * n + (i & 3); }

struct Unit { int pm, pn; };
struct Gemm { const bf16_t* A; const bf16_t* Bt; int lda, ldb, K, a_pn_bytes; };

struct StaticOrder {
    int nM, nN, nwg, G, c;
    __device__ void init(int M_, int N_, int G_, int c_) { nM = M_ / BM; nN = N_ / BM; nwg = nM * nN; G = G_; c = c_; }
    __device__ bool next(int i, Unit& u) const {
        const long L = (long)i * G + c; if (L >= nwg) return false;
        int wgid = (int)L; { const int q = nwg / NXCD, r = nwg % NXCD, xcd = wgid % NXCD, off = wgid / NXCD; wgid = (xcd < r ? xcd * (q + 1) : r * (q + 1) + (xcd - r) * q) + off; }
        const int nig = WGM * nN, gid = wgid / nig, fm = gid * WGM, gsz = (nM - fm) < WGM ? (nM - fm) : WGM;
        u.pm = fm + ((wgid % nig) % gsz); u.pn = (wgid % nig) / gsz; return true;
    }
};

template <class Epi, class Sched, bool ALIGN_EPI>
__device__ __forceinline__ void gemm_phase(LAS unsigned char* lds, const Gemm g, const Sched& S, const Epi& E, const int wid) {
    const int lane = lane_id_asm(), tid = wid * 64 + lane;
    const int wr = wid >> 2, wc = wid & 3, fr = lane & 15, fq = lane >> 4;
    const int nt = g.K / BK;
    unsigned voffA[2], voffB[2];
#pragma unroll
    for (int i = 0; i < 2; ++i) { int R, C; stage_rc(tid * 16 + i * 8192, R, C); const int Rb = (R & ~31) + perm32(R & 31);
        voffA[i] = (unsigned)(R * g.lda + C) * 2u; voffB[i] = (unsigned)(Rb * g.ldb + C) * 2u; }
    const size_t kstep = (size_t)(BK * 2);
    const size_t hA = (size_t)HALF * g.lda * 2, hB = (size_t)HALF * g.ldb * 2, tA = 2 * hA, tB = 2 * hB;
    const unsigned ldsw = (unsigned)wid * 1024u;
    const int aoff = lds_byte(wr * 64 + fr, fq * 8), boff = lds_byte(wc * 32 + fr, fq * 8);
#define PG8_SA(b, h) (((b) * 2 + (h)) * HTB)
#define PG8_SB(b, h) ((4 + (b) * 2 + (h)) * HTB)
#define PG8_STAGE(bufoff, gbase, voff) do { _Pragma("unroll") for (int _i = 0; _i < 2; ++_i) \
        __builtin_amdgcn_global_load_lds((const unsigned*)((const char*)(gbase) + (voff)[_i]), (LAS unsigned*)(lds + (bufoff) + ldsw + _i * 8192), 16, 0, 0); } while (0)
#define PG8_LDA(dst, b, h) do { _Pragma("unroll") for (int m = 0; m < 4; ++m) _Pragma("unroll") for (int k = 0; k < 2; ++k) dst[m][k] = *(const LAS bf16x8*)(lds + PG8_SA(b, h) + aoff + m * 2048 + k * 1024); } while (0)
#define PG8_LDB(dst, b, h) do { _Pragma("unroll") for (int n = 0; n < 2; ++n) _Pragma("unroll") for (int k = 0; k < 2; ++k) dst[n][k] = *(const LAS bf16x8*)(lds + PG8_SB(b, h) + boff + n * 2048 + k * 1024); } while (0)
#define PG8_MMA(ai, bj, At, Bt) do { __builtin_amdgcn_s_setprio(1); _Pragma("unroll") for (int m = 0; m < 4; ++m) _Pragma("unroll") for (int n = 0; n < 2; ++n) _Pragma("unroll") for (int k = 0; k < 2; ++k) \
        acc[ai][bj][m][n] = __builtin_amdgcn_mfma_f32_16x16x32_bf16(Bt[n][k], At[m][k], acc[ai][bj][m][n], 0, 0, 0); __builtin_amdgcn_s_setprio(0); } while (0)
#define PG8_WAIT_V(n) asm volatile("s_waitcnt vmcnt(" #n ")" ::: "memory")
#define PG8_WAIT_L(n) asm volatile("s_waitcnt lgkmcnt(" #n ")" ::: "memory")
#define PG8_BAR __builtin_amdgcn_s_barrier()
#define PG8_SCHED __builtin_amdgcn_sched_barrier(0)
    Unit cur, nxt; int ui = 0;
    if (!S.next(0, cur)) return;
    f32x4 acc[2][2][4][2];
#pragma unroll
    for (int a = 0; a < 2; ++a)
#pragma unroll
        for (int b = 0; b < 2; ++b)
#pragma unroll
            for (int m = 0; m < 4; ++m)
#pragma unroll
                for (int n = 0; n < 2; ++n) acc[a][b][m][n] = (f32x4){0.f, 0.f, 0.f, 0.f};
    bf16x8 At[4][2], B0[2][2], B1[2][2];
    const char* cA = (const char*)g.A + (size_t)cur.pm * tA + (size_t)cur.pn * g.a_pn_bytes; const char* cB = (const char*)g.Bt + (size_t)cur.pn * tB;
    PG8_STAGE(PG8_SB(0, 0), cB, voffB); PG8_STAGE(PG8_SB(0, 1), cB + hB, voffB); PG8_STAGE(PG8_SA(0, 0), cA, voffA); PG8_STAGE(PG8_SA(0, 1), cA + hA, voffA);
    if (wr == 1) PG8_BAR;
    PG8_WAIT_V(2); PG8_BAR;
    PG8_STAGE(PG8_SB(1, 0), cB + kstep, voffB); PG8_STAGE(PG8_SA(1, 0), cA + kstep, voffA); PG8_STAGE(PG8_SB(1, 1), cB + hB + kstep, voffB);
    PG8_WAIT_V(6); PG8_BAR;
    for (;;) {
        const bool has_next = S.next(ui + 1, nxt);
        const char* nA = has_next ? (const char*)g.A + (size_t)nxt.pm * tA + (size_t)nxt.pn * g.a_pn_bytes : cA; const char* nB = has_next ? (const char*)g.Bt + (size_t)nxt.pn * tB : cB;
        for (int t = 0; t < nt; t += 2) {
            const bool last = (t == nt - 2);
            const char* a1 = cA + (size_t)(t + 1) * kstep;
            const char* a2 = last ? nA : cA + (size_t)(t + 2) * kstep; const char* b2 = last ? nB : cB + (size_t)(t + 2) * kstep;
            const char* a3 = a2 + kstep; const char* b3 = b2 + kstep;
            PG8_LDB(B0, 0, 0); PG8_LDB(B1, 0, 1); PG8_SCHED; PG8_LDA(At, 0, 0); PG8_STAGE(PG8_SA(1, 1), a1 + hA, voffA);
            PG8_WAIT_V(8); PG8_WAIT_L(0); PG8_BAR; PG8_MMA(0, 0, At, B0); PG8_MMA(0, 1, At, B1); PG8_BAR; PG8_SCHED;
            PG8_LDA(At, 0, 1); PG8_STAGE(PG8_SB(0, 0), b2, voffB); PG8_STAGE(PG8_SB(0, 1), b2 + hB, voffB); PG8_STAGE(PG8_SA(0, 0), a2, voffA);
            PG8_WAIT_V(8); PG8_WAIT_L(0); PG8_BAR; PG8_MMA(1, 0, At, B0); PG8_MMA(1, 1, At, B1); PG8_BAR; PG8_SCHED;
            PG8_LDB(B0, 1, 0); PG8_LDB(B1, 1, 1); PG8_SCHED; PG8_LDA(At, 1, 0); PG8_STAGE(PG8_SA(0, 1), a2 + hA, voffA);
            PG8_WAIT_V(8); PG8_WAIT_L(0); PG8_BAR; PG8_MMA(0, 0, At, B0); PG8_MMA(0, 1, At, B1); PG8_BAR; PG8_SCHED;
            PG8_LDA(At, 1, 1); PG8_STAGE(PG8_SB(1, 0), b3, voffB); PG8_STAGE(PG8_SB(1, 1), b3 + hB, voffB); PG8_STAGE(PG8_SA(1, 0), a3, voffA);
            PG8_WAIT_V(8); PG8_WAIT_L(0); PG8_BAR; PG8_MMA(1, 0, At, B0); PG8_MMA(1, 1, At, B1); PG8_BAR; PG8_SCHED;
        }
        if constexpr (ALIGN_EPI) { if (wr == 0) PG8_BAR; }
        E(acc, cur, wr, wc, fr, fq);
        if (!has_next) break;
#pragma unroll
        for (int a = 0; a < 2; ++a)
#pragma unroll
            for (int b = 0; b < 2; ++b)
#pragma unroll
                for (int m = 0; m < 4; ++m)
#pragma unroll
                    for (int n = 0; n < 2; ++n) acc[a][b][m][n] = (f32x4){0.f, 0.f, 0.f, 0.f};
        cur = nxt; cA = nA; cB = nB; ++ui;
        if constexpr (ALIGN_EPI) { if (wr == 1) PG8_BAR; }
    }
    PG8_WAIT_V(0);
    if constexpr (!ALIGN_EPI) { if (wr == 0) PG8_BAR; }
    PG8_BAR;
#undef PG8_SA
#undef PG8_SB
#undef PG8_STAGE
#undef PG8_LDA
#undef PG8_LDB
#undef PG8_MMA
#undef PG8_WAIT_V
#undef PG8_WAIT_L
#undef PG8_BAR
#undef PG8_SCHED
}

__device__ __forceinline__ unsigned cvt_pk_bf16(float lo, float hi) { f32x2 v = {lo, hi}; bf16x2_t b = __builtin_convertvector(v, bf16x2_t); return __builtin_bit_cast(unsigned, b); }
__device__ __forceinline__ float silu_f(float x) { return x * __builtin_amdgcn_rcpf(1.0f + __builtin_amdgcn_exp2f(-LOG2E * x)); }

struct EpiSwiGLU {
    bf16_t* O;
    __device__ __forceinline__ void operator()(const f32x4 (&acc)[2][2][4][2], const Unit& u, int wr, int wc, int fr, int fq) const {
        const int row0 = u.pm * BM + wr * 64 + fr, col0 = u.pn * 128 + wc * 32 + 8 * fq;
#pragma unroll
        for (int ai = 0; ai < 2; ++ai)
#pragma unroll
            for (int m = 0; m < 4; ++m) {
                bf16_t* rowp = O + (size_t)(row0 + ai * HALF + m * 16) * DFF + col0;
                const f32x4 g0 = acc[ai][0][m][0], g1 = acc[ai][0][m][1], u0 = acc[ai][1][m][0], u1 = acc[ai][1][m][1];
                u32x4 w;
                w.x = cvt_pk_bf16(silu_f(g0[0]) * u0[0], silu_f(g0[1]) * u0[1]); w.y = cvt_pk_bf16(silu_f(g0[2]) * u0[2], silu_f(g0[3]) * u0[3]);
                w.z = cvt_pk_bf16(silu_f(g1[0]) * u1[0], silu_f(g1[1]) * u1[1]); w.w = cvt_pk_bf16(silu_f(g1[2]) * u1[2], silu_f(g1[3]) * u1[3]);
                *(u32x4*)rowp = w;
                asm volatile("" ::: "memory");
            }
    }
};
struct EpiResid {
    float* H;
    __device__ __forceinline__ void operator()(const f32x4 (&acc)[2][2][4][2], const Unit& u, int wr, int wc, int fr, int fq) const {
        const int row0 = u.pm * BM + wr * 64 + fr, col0 = u.pn * BM + wc * 32 + 8 * fq;
#pragma unroll
        for (int ai = 0; ai < 2; ++ai)
#pragma unroll
            for (int m = 0; m < 4; ++m) {
                const int row = row0 + ai * HALF + m * 16;
                if (row < M) {
                    float* rowp = H + (size_t)row * D + col0;
#pragma unroll
                    for (int bj = 0; bj < 2; ++bj)
#pragma unroll
                        for (int n = 0; n < 2; ++n) { f32x4* p = (f32x4*)(rowp + bj * HALF + 4 * n); const f32x4 v = *p; *p = v * ALPHA + acc[ai][bj][m][n]; }
                }
            }
    }
};
struct EpiOutProj {
    float* H;
    __device__ __forceinline__ void operator()(const f32x4 (&acc)[2][2][4][2], const Unit& u, int wr, int wc, int fr, int fq) const {
        const int b = u.pm / 17; const int minrow = (u.pm - b * 17 == 0) ? PADF : 0;
        const int lrow0 = wr * 64 + fr, col0 = u.pn * BM + wc * 32 + 8 * fq;
        float* base = H + ((size_t)(u.pm * BM) - (size_t)(PADF * (b + 1))) * D + col0;
#pragma unroll
        for (int ai = 0; ai < 2; ++ai)
#pragma unroll
            for (int m = 0; m < 4; ++m) {
                const int lrow = lrow0 + ai * HALF + m * 16;
                if (lrow >= minrow) {
                    float* rowp = base + (size_t)lrow * D;
#pragma unroll
                    for (int bj = 0; bj < 2; ++bj)
#pragma unroll
                        for (int n = 0; n < 2; ++n) { f32x4* p = (f32x4*)(rowp + bj * HALF + 4 * n); const f32x4 v = *p; *p = v * ALPHA + acc[ai][bj][m][n]; }
                }
                asm volatile("" ::: "memory");
            }
    }
};
struct EpiPool {
    const float* x; const float* meta; const float* scale; float* H;
    __device__ __forceinline__ void operator()(const f32x4 (&acc)[2][2][4][2], const Unit& u, int wr, int wc, int fr, int fq) const {
        const int row0 = u.pm * BM + wr * 64 + fr, col0 = u.pn * BM + wc * 32 + 8 * fq;
        const int blo = (u.pm * BM) / LSEQ, bound = (blo + 1) * LSEQ;
#pragma unroll
        for (int ai = 0; ai < 2; ++ai)
#pragma unroll
            for (int m = 0; m < 4; ++m) {
                const int row = row0 + ai * HALF + m * 16;
                if (row < M) {
                    const int b = blo + (row >= bound ? 1 : 0), p = row - b * LSEQ;
                    const float* src = (p < NMETA ? meta + (size_t)p * D : x + (size_t)(row - NMETA * (b + 1)) * D) + col0;
                    float* rowp = H + (size_t)row * D + col0;
#pragma unroll
                    for (int bj = 0; bj < 2; ++bj)
#pragma unroll
                        for (int n = 0; n < 2; ++n) { const f32x4 v = *(const f32x4*)(src + bj * HALF + 4 * n); const f32x4 sc = *(const f32x4*)(scale + col0 + bj * HALF + 4 * n);
                            *(f32x4*)(rowp + bj * HALF + 4 * n) = v * ALPHA + acc[ai][bj][m][n] * sc; }
                }
                asm volatile("" ::: "memory");
            }
    }
};
struct EpiQKV {
    bf16_t* QKV; float* LF;
    __device__ __forceinline__ void operator()(const f32x4 (&acc)[2][2][4][2], const Unit& u, int wr, int wc, int fr, int fq) const {
        const int row0 = u.pm * BM + wr * 64 + fr; const int t = u.pn >> 2;
        const int blo = (u.pm * BM) / LSEQ, bound = (blo + 1) * LSEQ;
        if (t < 3) {
            bf16_t* base = QKV + (size_t)t * ((WS_K - WS_Q) / 2); const float sc = (t == 0) ? QSCALE : 1.0f;
            const int col0 = (u.pn & 3) * BM + wc * 32 + 8 * fq;
#pragma unroll
            for (int ai = 0; ai < 2; ++ai)
#pragma unroll
                for (int m = 0; m < 4; ++m) {
                    const int row = row0 + ai * HALF + m * 16;
                    if (row < M) {
                        const int prow = row + PADF * (blo + 1) + (row >= bound ? PADF : 0);
                        bf16_t* rowp = base + (size_t)prow * D + col0;
#pragma unroll
                        for (int bj = 0; bj < 2; ++bj) { const f32x4 v0 = acc[ai][bj][m][0] * sc, v1 = acc[ai][bj][m][1] * sc;
                            u32x4 w; w.x = cvt_pk_bf16(v0[0], v0[1]); w.y = cvt_pk_bf16(v0[2], v0[3]); w.z = cvt_pk_bf16(v1[0], v1[1]); w.w = cvt_pk_bf16(v1[2], v1[3]);
                            *(u32x4*)(rowp + bj * HALF) = w; }
                    }
                    asm volatile("" ::: "memory");
                }
        } else if (wc == 0 && fq < 2) {
#pragma unroll
            for (int ai = 0; ai < 2; ++ai)
#pragma unroll
                for (int m = 0; m < 4; ++m) {
                    const int row = row0 + ai * HALF + m * 16;
                    if (row < M) {
#pragma unroll
                        for (int n = 0; n < 2; ++n) *(f32x4*)(LF + (size_t)row * 16 + 8 * fq + 4 * n) = acc[ai][0][m][n];
                    }
                }
        }
    }
};
}

__device__ __forceinline__ float wave_sum(float v) {
#pragma unroll
    for (int o = 1; o < 64; o <<= 1) v += __shfl_xor(v, o);
    return v;
}
__device__ __forceinline__ unsigned pk2(float lo, float hi) { return pg8::cvt_pk_bf16(lo, hi); }

__device__ __forceinline__ void transpose_item(const float* W, int ldw, int k0, int n0, int n_valid, bf16_t* WT, int ldwt, int dst_row0, LAS float* scr, int lane) {
#pragma unroll 8
    for (int i = 0; i < 32; ++i) { const int kk = 2 * i + (lane >> 5); const int n = n0 + (lane & 31); scr[kk * 33 + (lane & 31)] = (n < n_valid) ? W[(size_t)(k0 + kk) * ldw + n] : 0.f; }
    asm volatile("s_waitcnt lgkmcnt(0)" ::: "memory");
    const int c = lane & 7;
#pragma unroll
    for (int j = 0; j < 4; ++j) { const int n = (lane >> 3) + 8 * j; const LAS float* s = scr + (8 * c) * 33 + n;
        u32x4 o; o.x = pk2(s[0 * 33], s[1 * 33]); o.y = pk2(s[2 * 33], s[3 * 33]); o.z = pk2(s[4 * 33], s[5 * 33]); o.w = pk2(s[6 * 33], s[7 * 33]);
        *(u32x4*)(WT + (size_t)(dst_row0 + n) * ldwt + k0 + 8 * c) = o; }
    asm volatile("s_waitcnt lgkmcnt(0)" ::: "memory");
}

struct Args {
    const float* x; const float* meta; const float* pool_w; const float* pool_scale; const float* w_in; const float* b_f; const float* w_o;
    const float* w_gate; const float* w_up; const float* w_down; const float* ln_g; const float* ln_b;
    float* out; unsigned char* ws;
};

__device__ __forceinline__ void phase_prologue(const Args& a, LAS unsigned char* lds, int gw, int NGW, int wave, int lane) {
    unsigned char* ws = a.ws;
    LAS float* scr = (LAS float*)(lds + wave * 16384);
    constexpr int I_POOL = 4 * 4 * 8;
    constexpr int I_GU = 16 * 88;
    constexpr int I_DN = 44 * 32;
    constexpr int I_IN = 16 * 104;
    constexpr int I_O = 16 * 32;
    constexpr int NITEMS = I_POOL + 4 * I_GU + 2 * I_DN + I_IN + I_O;
    for (int it = gw; it < NITEMS; it += NGW) {
        int r = it;
        if (r < I_POOL) { const int g = r / 32, rr = r % 32, kb = rr / 8, nb = rr % 8;
            transpose_item(a.pool_w + (size_t)g * 65536, 256, 64 * kb, 32 * nb, 256, (bf16_t*)(ws + WS_WPOOL), 256, g * 256 + 32 * nb, scr, lane); continue; }
        r -= I_POOL;
        if (r < 4 * I_GU) { const int which = r / I_GU, rr = r % I_GU, layer = which >> 1, up = which & 1, kb = rr / 88, nb = rr % 88, n0 = 32 * nb;
            const float* W = (up ? a.w_up : a.w_gate) + (size_t)layer * D * DFF;
            bf16_t* WT = (bf16_t*)(ws + (layer ? WS_WGU1 : WS_WGU0));
            transpose_item(W, DFF, 64 * kb, n0, DFF, WT, D, (n0 / 128) * 256 + up * 128 + (n0 % 128), scr, lane); continue; }
        r -= 4 * I_GU;
        if (r < 2 * I_DN) { const int layer = r / I_DN, rr = r % I_DN, kb = rr / 32, nb = rr % 32;
            transpose_item(a.w_down + (size_t)layer * DFF * D, D, 64 * kb, 32 * nb, D, (bf16_t*)(ws + (layer ? WS_WD1 : WS_WD0)), DFF, 32 * nb, scr, lane); continue; }
        r -= 2 * I_DN;
        if (r < I_IN) { const int kb = r / 104, nb = r % 104;
            transpose_item(a.w_in, 3 * D + NH, 64 * kb, 32 * nb, 3 * D + NH, (bf16_t*)(ws + WS_WIN), D, 32 * nb, scr, lane); continue; }
        r -= I_IN;
        { const int kb = r / 32, nb = r % 32; transpose_item(a.w_o, D, 64 * kb, 32 * nb, D, (bf16_t*)(ws + WS_WO), D, 32 * nb, scr, lane); }
    }
    bf16_t* Y = (bf16_t*)(ws + WS_ACT);
    constexpr int CH_PER_B = LSEQ / 16;
    for (int ck = gw; ck < BATCH * CH_PER_B; ck += NGW) {
        const int b = ck / CH_PER_B, r0 = (ck % CH_PER_B) * 16;
        f32x4 S[4];
#pragma unroll
        for (int g = 0; g < 4; ++g) S[g] = (f32x4){0.f, 0.f, 0.f, 0.f};
#define H0ROW(p) (((p) < NMETA) ? a.meta + (size_t)(p) * D : a.x + ((size_t)b * SEQ + ((p) - NMETA)) * D)
#pragma unroll
        for (int g = 0; g < 4; ++g) { const int w = 2 << g;
            for (int s = r0 - w + 1; s < r0; ++s) if (s >= 0) S[g] += *(const f32x4*)(H0ROW(s) + g * 256 + lane * 4); }
        for (int p = r0; p < r0 + 16; ++p) {
            const float* cur = H0ROW(p);
#pragma unroll
            for (int g = 0; g < 4; ++g) { const int w = 2 << g;
                const f32x4 xv = *(const f32x4*)(cur + g * 256 + lane * 4);
                S[g] += xv;
                const int cnt = (p + 1 < w) ? (p + 1) : w;
                const f32x4 y = S[g] * (1.0f / (float)cnt) - xv;
                u32x2 o; o.x = pk2(y[0], y[1]); o.y = pk2(y[2], y[3]);
                *(u32x2*)(Y + (size_t)(b * LSEQ + p) * D + g * 256 + lane * 4) = o;
                const int sub = p - w + 1;
                if (sub >= 0) S[g] -= *(const f32x4*)(H0ROW(sub) + g * 256 + lane * 4);
            }
        }
#undef H0ROW
    }
}

template <bool FINAL>
__device__ __forceinline__ void phase_ln(const Args& a, const float* g, const float* bta, int gw, int NGW, int lane) {
    float* H = (float*)(a.ws + WS_H); bf16_t* HB = (bf16_t*)(a.ws + WS_HB);
    f32x4 gv[4], bv[4];
#pragma unroll
    for (int j = 0; j < 4; ++j) { gv[j] = *((const f32x4*)g + lane + 64 * j); bv[j] = *((const f32x4*)bta + lane + 64 * j); }
    for (int m = gw; m < M; m += NGW) {
        f32x4* xr = (f32x4*)(H + (size_t)m * D) + lane;
        f32x4 v[4]; float s = 0.f;
#pragma unroll
        for (int j = 0; j < 4; ++j) { v[j] = xr[64 * j]; s += (v[j].x + v[j].y) + (v[j].z + v[j].w); }
        const float mean = wave_sum(s) * (1.f / D); float s2 = 0.f;
#pragma unroll
        for (int j = 0; j < 4; ++j) { v[j] = v[j] - mean; s2 += (v[j].x * v[j].x + v[j].y * v[j].y) + (v[j].z * v[j].z + v[j].w * v[j].w); }
        const float rstd = 1.f / sqrtf(wave_sum(s2) * (1.f / D) + LN_EPS);
        if (FINAL) {
            const int b = m / LSEQ, p = m - b * LSEQ;
            if (p >= NMETA) { f32x4* o = (f32x4*)(a.out + ((size_t)b * SEQ + (p - NMETA)) * D) + lane;
#pragma unroll
                for (int j = 0; j < 4; ++j) o[64 * j] = v[j] * rstd * gv[j] + bv[j]; }
        } else {
            u32x2* o8 = (u32x2*)(HB + (size_t)m * D) + lane;
#pragma unroll
            for (int j = 0; j < 4; ++j) { const f32x4 y = v[j] * rstd * gv[j] + bv[j]; xr[64 * j] = y; u32x2 w; w.x = pk2(y.x, y.y); w.y = pk2(y.z, y.w); o8[64 * j] = w; }
        }
    }
}

__device__ __forceinline__ float log2_sigmoid(float xx) { return -LOG2E * (fmaxf(-xx, 0.f) + log1pf(__expf(-fabsf(xx)))); }
__device__ __forceinline__ void phase_cumsum(const Args& a, int gw, int NGW, int lane) {
    const float* LF = (const float*)(a.ws + WS_LF); float* C2 = (float*)(a.ws + WS_C2);
    for (int bh = gw; bh < BATCH * NH; bh += NGW) {
        const int b = bh >> 4, h = bh & 15;
        const float bias = a.b_f[h];
        const int p0 = lane * 65; const int p1 = (p0 + 65 < LSEQ) ? p0 + 65 : LSEQ;
        float sum = 0.f;
        for (int p = p0; p < p1; ++p) sum += log2_sigmoid(LF[(size_t)(b * LSEQ + p) * 16 + h] + bias);
        float incl = sum;
#pragma unroll
        for (int off = 1; off < 64; off <<= 1) { const float t = __shfl_up(incl, off); if (lane >= off) incl += t; }
        float run = incl - sum;
        for (int p = p0; p < p1; ++p) { run += log2_sigmoid(LF[(size_t)(b * LSEQ + p) * 16 + h] + bias); C2[(size_t)bh * LPAD + PADF + p] = run; }
        for (int i = lane; i < PADF; i += 64) C2[(size_t)bh * LPAD + i] = 0.f;
    }
    for (int r = gw; r < 3 * BATCH * PADF; r += NGW) {
        const int t = r / (BATCH * PADF), rr = r % (BATCH * PADF), b = rr / PADF, pp = rr % PADF;
        bf16_t* base = (bf16_t*)(a.ws + (t == 0 ? WS_Q : t == 1 ? WS_K : WS_V)) + (size_t)(b * LPAD + pp) * D;
        u32x4 z = {0u, 0u, 0u, 0u};
        *((u32x4*)base + lane) = z; *((u32x4*)base + 64 + lane) = z;
    }
}

namespace att {
constexpr int RSK = 144, RSV = 192, KBUF = 64 * RSK, VBUF = 64 * RSV;
constexpr int OFF_K = 0, OFF_V = 2 * KBUF, OFF_C = OFF_V + 2 * VBUF, OFF_W = OFF_C + 2 * 256, TOTAL = OFF_W + 8 * 256;
static_assert(TOTAL <= 131072, "attention LDS");
constexpr int NQB = LPAD / 256;
constexpr int NUNITS = BATCH * NH * NQB;
__device__ __forceinline__ int crow(int r, int hi) { return (r & 3) + 8 * (r >> 2) + 4 * hi; }

__device__ __forceinline__ void attn_unit(int bh, int qb, const bf16_t* Q, const bf16_t* K, const bf16_t* V, bf16_t* O, const float* C2, LAS unsigned char* lds, const int wid) {
    const int lane = lane_id_asm(), tid = wid * 64 + lane, r32 = lane & 31, hi = lane >> 5;
    const int b = bh >> 4, h = bh & 15;
    const size_t rowbase = (size_t)b * LPAD;
    const int qw0 = qb * 256 + wid * 32, myq = qw0 + r32;
    bf16x8 qr[4];
    { const bf16_t* Qp = Q + (rowbase + myq) * D + h * HD;
#pragma unroll
      for (int d0 = 0; d0 < 4; ++d0) qr[d0] = *(const bf16x8*)(Qp + d0 * 16 + hi * 8); }
    const float cq = C2[(size_t)bh * LPAD + myq];
    float m_run = NEGBIG, l_run = 0.f;
    f32x16 o[2];
#pragma unroll
    for (int r = 0; r < 16; ++r) { o[0][r] = 0.f; o[1][r] = 0.f; }
    const int thi = 4 * qb + 3;
    const int srow = tid >> 3, sch = tid & 7;
    const bf16_t* gK = K + (rowbase + srow) * D + h * HD + sch * 8;
    const bf16_t* gV = V + (rowbase + srow) * D + h * HD + sch * 8;
    const float* gC = C2 + (size_t)bh * LPAD;
    LAS float* wsf = (LAS float*)(lds + OFF_W) + wid * 64;
    { const u32x4 kv = *(const u32x4*)(gK + (size_t)thi * 64 * D), vv = *(const u32x4*)(gV + (size_t)thi * 64 * D);
      *(LAS u32x4*)(lds + OFF_K + srow * RSK + sch * 16) = kv; *(LAS u32x4*)(lds + OFF_V + srow * RSV + sch * 16) = vv;
      if (tid < 64) *(LAS float*)(lds + OFF_C + tid * 4) = gC[thi * 64 + tid]; }
    __syncthreads();
    const int i16 = lane & 15, q4 = i16 >> 2, p4 = i16 & 3, blk = (lane >> 4) & 1;
    const int vtr_off = (4 * hi + q4) * RSV + (16 * blk + 4 * p4) * 2;
    int it = 0;
    for (int t = thi; t >= 3; --t, ++it) {
        const int buf = it & 1;
        u32x4 kvn = {0u, 0u, 0u, 0u}, vvn = {0u, 0u, 0u, 0u}; float cn = 0.f;
        if (t > 3) { kvn = *(const u32x4*)(gK + (size_t)(t - 1) * 64 * D); vvn = *(const u32x4*)(gV + (size_t)(t - 1) * 64 * D); if (tid < 64) cn = gC[(t - 1) * 64 + tid]; }
        const int k0 = t * 64;
        if (k0 <= qw0 + 31) {
            const LAS unsigned char* Kb = lds + OFF_K + buf * KBUF; const LAS unsigned char* Vb = lds + OFF_V + buf * VBUF;
            const LAS float* ckp = (const LAS float*)(lds + OFF_C + buf * 256);
            f32x16 p0, p1;
#pragma unroll
            for (int r = 0; r < 16; ++r) { p0[r] = 0.f; p1[r] = 0.f; }
#pragma unroll
            for (int d0 = 0; d0 < 4; ++d0) {
                const bf16x8 a0 = *(const LAS bf16x8*)(Kb + r32 * RSK + (d0 * 16 + hi * 8) * 2);
                const bf16x8 a1 = *(const LAS bf16x8*)(Kb + (32 + r32) * RSK + (d0 * 16 + hi * 8) * 2);
                p0 = __builtin_amdgcn_mfma_f32_32x32x16_bf16(a0, qr[d0], p0, 0, 0, 0);
                p1 = __builtin_amdgcn_mfma_f32_32x32x16_bf16(a1, qr[d0], p1, 0, 0, 0);
            }
#pragma unroll
            for (int g = 0; g < 4; ++g) {
                const f32x4 c0 = *(const LAS f32x4*)(ckp + 8 * g + 4 * hi), c1 = *(const LAS f32x4*)(ckp + 32 + 8 * g + 4 * hi);
#pragma unroll
                for (int j = 0; j < 4; ++j) { p0[4 * g + j] += cq - c0[j]; p1[4 * g + j] += cq - c1[j]; }
            }
            if (t == 3 || k0 + 63 > qw0) {
#pragma unroll
                for (int r = 0; r < 16; ++r) { const int kv = k0 + crow(r, hi);
                    if (kv > myq || kv < PADF) p0[r] = NEGBIG;
                    if (kv + 32 > myq || kv + 32 < PADF) p1[r] = NEGBIG; }
            }
            float mx = fmaxf(p0[0], p1[0]);
#pragma unroll
            for (int r = 1; r < 16; ++r) mx = fmaxf(mx, fmaxf(p0[r], p1[r]));
            mx = fmaxf(mx, __shfl_xor(mx, 32));
            const float m_new = fmaxf(m_run, mx);
            if (__any(m_new > m_run)) {
                const float alpha = __builtin_amdgcn_exp2f(m_run - m_new);
                l_run *= alpha;
                if (hi == 0) wsf[r32] = alpha;
                asm volatile("s_waitcnt lgkmcnt(0)" ::: "memory");
#pragma unroll
                for (int g = 0; g < 4; ++g) { const f32x4 f = *(const LAS f32x4*)(wsf + 8 * g + 4 * hi);
#pragma unroll
                    for (int j = 0; j < 4; ++j) { o[0][4 * g + j] *= f[j]; o[1][4 * g + j] *= f[j]; } }
                asm volatile("s_waitcnt lgkmcnt(0)" ::: "memory");
                m_run = m_new;
            }
            float ls = 0.f;
#pragma unroll
            for (int r = 0; r < 16; ++r) { p0[r] = __builtin_amdgcn_exp2f(p0[r] - m_run); p1[r] = __builtin_amdgcn_exp2f(p1[r] - m_run); ls += p0[r] + p1[r]; }
            l_run += ls;
            bf16x8 pa[4];
#pragma unroll
            for (int s = 0; s < 4; ++s) { u32x4 w;
#pragma unroll
                for (int j = 0; j < 4; ++j) { const int r = 8 * (s & 1) + 2 * j; w[j] = (s < 2) ? pg8::cvt_pk_bf16(p0[r], p0[r + 1]) : pg8::cvt_pk_bf16(p1[r], p1[r + 1]); }
                pa[s] = __builtin_bit_cast(bf16x8, w); }
#pragma unroll
            for (int d0 = 0; d0 < 2; ++d0)
#pragma unroll
                for (int s = 0; s < 4; ++s) {
                    const LAS unsigned char* vp = Vb + vtr_off + (16 * s) * RSV + d0 * 64;
                    const s16x4 lo = __builtin_bit_cast(s16x4, __builtin_amdgcn_ds_read_tr16_b64_v4i16((LAS s16x4*)vp));
                    const s16x4 hh = __builtin_bit_cast(s16x4, __builtin_amdgcn_ds_read_tr16_b64_v4i16((LAS s16x4*)(vp + 8 * RSV)));
                    const bf16x8 vb = __builtin_shufflevector(lo, hh, 0, 1, 2, 3, 4, 5, 6, 7);
                    o[d0] = __builtin_amdgcn_mfma_f32_32x32x16_bf16(pa[s], vb, o[d0], 0, 0, 0);
                }
        }
        if (t > 3) {
            const int nb = buf ^ 1;
            *(LAS u32x4*)(lds + OFF_K + nb * KBUF + srow * RSK + sch * 16) = kvn; *(LAS u32x4*)(lds + OFF_V + nb * VBUF + srow * RSV + sch * 16) = vvn;
            if (tid < 64) *(LAS float*)(lds + OFF_C + nb * 256 + tid * 4) = cn;
        }
        __syncthreads();
    }
    float l_tot = l_run + __shfl_xor(l_run, 32);
    if (hi == 0) wsf[r32] = 1.0f / l_tot;
    asm volatile("s_waitcnt lgkmcnt(0)" ::: "memory");
    bf16_t* Op = O + (rowbase + qw0) * D + h * HD + r32;
#pragma unroll
    for (int g = 0; g < 4; ++g) { const f32x4 f = *(const LAS f32x4*)(wsf + 8 * g + 4 * hi);
#pragma unroll
        for (int j = 0; j < 4; ++j) { const int r = 4 * g + j; const int qrow = crow(r, hi);
            const unsigned w0 = pg8::cvt_pk_bf16(o[0][r] * f[j], 0.f), w1 = pg8::cvt_pk_bf16(o[1][r] * f[j], 0.f);
            Op[(size_t)qrow * D] = (bf16_t)(w0 & 0xffffu); Op[(size_t)qrow * D + 32] = (bf16_t)(w1 & 0xffffu); } }
    asm volatile("s_waitcnt lgkmcnt(0)" ::: "memory");
    __syncthreads();
}
}

__global__ void __launch_bounds__(512, 2) fwd_megakernel(Args a) {
    extern __shared__ __attribute__((aligned(16))) unsigned char lds_raw[];
    LAS unsigned char* lds = (LAS unsigned char*)lds_raw;
    const int wave = __builtin_amdgcn_readfirstlane(threadIdx.x >> 6);
    const int G = gridDim.x, bx = blockIdx.x;
    const int vcu = (G % 8 == 0) ? (bx % 8) * (G / 8) + bx / 8 : bx;
    const int gw = vcu * 8 + wave, NGW = G * 8;
    unsigned char* ws = a.ws;
    float* H = (float*)(ws + WS_H); bf16_t* HB = (bf16_t*)(ws + WS_HB); bf16_t* ACT = (bf16_t*)(ws + WS_ACT);
    unsigned* barctr = (unsigned*)(ws + WS_CTL) + 64; unsigned nbar = 0;
#define LANE() lane_id_asm()
#define GSYNC() do { ++nbar; grid_bar(barctr, nbar * (unsigned)G, wave); } while (0)

    phase_prologue(a, lds, gw, NGW, wave, LANE());
    cg::this_grid().sync();
    { pg8::Gemm g{ACT, (const bf16_t*)(ws + WS_WPOOL), D, 256, 256, 512}; pg8::StaticOrder S; S.init(MP, D, G, bx);
      pg8::EpiPool E{a.x, a.meta, a.pool_scale, H};
      pg8::gemm_phase<pg8::EpiPool, pg8::StaticOrder, true>(lds, g, S, E, wave); }
    GSYNC();
    phase_ln<false>(a, a.ln_g, a.ln_b, gw, NGW, LANE());
    GSYNC();
#define FFN_PHASES(layer) do { \
        { pg8::Gemm g{HB, (const bf16_t*)(ws + ((layer) ? WS_WGU1 : WS_WGU0)), D, D, D, 0}; pg8::StaticOrder S; S.init(MP, 2 * DFF, G, bx); \
          pg8::EpiSwiGLU E{ACT}; \
          pg8::gemm_phase<pg8::EpiSwiGLU, pg8::StaticOrder, true>(lds, g, S, E, wave); } \
        GSYNC(); \
        { pg8::Gemm g{ACT, (const bf16_t*)(ws + ((layer) ? WS_WD1 : WS_WD0)), DFF, DFF, DFF, 0}; pg8::StaticOrder S; S.init(MP, D, G, bx); \
          pg8::EpiResid E{H}; \
          pg8::gemm_phase<pg8::EpiResid, pg8::StaticOrder, true>(lds, g, S, E, wave); } \
        GSYNC(); } while (0)
    FFN_PHASES(0);
    phase_ln<false>(a, a.ln_g + D, a.ln_b + D, gw, NGW, LANE());
    GSYNC();
    { pg8::Gemm g{HB, (const bf16_t*)(ws + WS_WIN), D, D, D, 0}; pg8::StaticOrder S; S.init(MP, NIN, G, bx);
      pg8::EpiQKV E{(bf16_t*)(ws + WS_Q), (float*)(ws + WS_LF)};
      pg8::gemm_phase<pg8::EpiQKV, pg8::StaticOrder, true>(lds, g, S, E, wave); }
    GSYNC();
    phase_cumsum(a, gw, NGW, LANE());
    GSYNC();
    { unsigned* ctr = (unsigned*)(ws + WS_CTL); LAS unsigned* sh = (LAS unsigned*)(lds + LDSCTL_OFF);
      for (;;) {
          if (wave == 0 && LANE() == 0) sh[0] = atomicAdd(ctr, 1u);
          __syncthreads();
          const unsigned idx = sh[0];
          __syncthreads();
          if (idx >= (unsigned)att::NUNITS) break;
          const int qb = att::NQB - 1 - (int)(idx / (BATCH * NH)), bh = (int)(idx % (BATCH * NH));
          att::attn_unit(bh, qb, (const bf16_t*)(ws + WS_Q), (const bf16_t*)(ws + WS_K), (const bf16_t*)(ws + WS_V), (bf16_t*)(ws + WS_Q), (const float*)(ws + WS_C2), lds, wave);
      } }
    GSYNC();
    { pg8::Gemm g{(const bf16_t*)(ws + WS_Q), (const bf16_t*)(ws + WS_WO), D, D, D, 0}; pg8::StaticOrder S; S.init(MA, D, G, bx);
      pg8::EpiOutProj E{H};
      pg8::gemm_phase<pg8::EpiOutProj, pg8::StaticOrder, true>(lds, g, S, E, wave); }
    GSYNC();
    phase_ln<false>(a, a.ln_g + 2 * D, a.ln_b + 2 * D, gw, NGW, LANE());
    GSYNC();
    FFN_PHASES(1);
    phase_ln<true>(a, a.ln_g + 3 * D, a.ln_b + 3 * D, gw, NGW, LANE());
}

extern "C" void kernel_launch(void* const* d_in, const int* in_sizes, int n_in, void* d_out, int out_size, void* d_ws, size_t ws_size, hipStream_t stream) {
    static int grid = 0;
    if (grid == 0) {
        if (n_in != 12 || ws_size < WS_END) { fprintf(stderr, "kernel_launch: unexpected n_in %d / ws_size %zu\n", n_in, ws_size); grid = -1; return; }
        int dev = 0, cus = 0, per_cu = 0;
        hipGetDevice(&dev);
        hipDeviceGetAttribute(&cus, hipDeviceAttributeMultiprocessorCount, dev);
        hipFuncSetAttribute((const void*)fwd_megakernel, hipFuncAttributeMaxDynamicSharedMemorySize, LDS_BYTES);
        hipOccupancyMaxActiveBlocksPerMultiprocessor(&per_cu, (const void*)fwd_megakernel, 512, LDS_BYTES);
        if (per_cu < 1) { fprintf(stderr, "kernel_launch: occupancy query says %d blocks per CU\n", per_cu); grid = -1; return; }
        grid = cus;
    }
    if (grid < 0) return;
    hipMemsetAsync((char*)d_ws + WS_CTL, 0, 4096, stream);
    Args a{};
    a.x = (const float*)d_in[0]; a.meta = (const float*)d_in[1]; a.pool_w = (const float*)d_in[2]; a.pool_scale = (const float*)d_in[3];
    a.w_in = (const float*)d_in[4]; a.b_f = (const float*)d_in[5]; a.w_o = (const float*)d_in[6];
    a.w_gate = (const float*)d_in[7]; a.w_up = (const float*)d_in[8]; a.w_down = (const float*)d_in[9]; a.ln_g = (const float*)d_in[10]; a.ln_b = (const float*)d_in[11];
    a.out = (float*)d_out; a.ws = (unsigned char*)d_ws;
    void* args[] = {&a};
    hipError_t e = hipLaunchCooperativeKernel((const void*)fwd_megakernel, dim3(grid), dim3(512), args, LDS_BYTES, stream);
    if (e != hipSuccess) fprintf(stderr, "cooperative launch failed: %s (grid %d)\n", hipGetErrorString(e), grid);
}
```

```cpp
#include <hip/hip_runtime.h>
#include <hip/hip_cooperative_groups.h>
#include <cstdio>
#include <cstdint>
namespace cg = cooperative_groups;

#define LAS __attribute__((address_space(3)))
typedef unsigned short bf16_t;
typedef short bf16x8 __attribute__((ext_vector_type(8)));
typedef short s16x4 __attribute__((ext_vector_type(4)));
typedef float f32x4 __attribute__((ext_vector_type(4)));
typedef float f32x2 __attribute__((ext_vector_type(2)));
typedef float f32x16 __attribute__((ext_vector_type(16)));
typedef unsigned u32x4 __attribute__((ext_vector_type(4)));
typedef unsigned u32x2 __attribute__((ext_vector_type(2)));
typedef __bf16 bf16x2_t __attribute__((ext_vector_type(2)));

constexpr int BATCH = 8, SEQ = 4096, NMETA = 16, LSEQ = SEQ + NMETA;
constexpr int D = 1024, DFF = 2816, NH = 16, HD = 64;
constexpr int M = BATCH * LSEQ;
constexpr int MP = 33024;
constexpr int LPAD = 4352, PADF = 240;
constexpr int MA = BATCH * LPAD;
constexpr int NIN = 3328;
constexpr float ALPHA = 1.41421356237309515f;
constexpr float LN_EPS = 1e-5f;
constexpr float LOG2E = 1.4426950408889634f;
constexpr float QSCALE = 0.125f * LOG2E;
constexpr float NEGBIG = -1e30f;

constexpr size_t MiB = 1u << 20;
constexpr size_t WS_CTL = 0;
constexpr size_t WS_WPOOL = 1 * MiB, WS_WGU0 = 2 * MiB, WS_WD0 = 13 * MiB, WS_WIN = 19 * MiB, WS_WO = 26 * MiB, WS_WGU1 = 28 * MiB, WS_WD1 = 39 * MiB;
constexpr size_t WS_H = 45 * MiB;
constexpr size_t WS_HB = 174 * MiB;
constexpr size_t WS_O = WS_HB;
constexpr size_t WS_ACT = 242 * MiB;
constexpr size_t WS_Q = 242 * MiB, WS_K = 310 * MiB, WS_V = 378 * MiB;
constexpr size_t WS_LF = 446 * MiB;
constexpr size_t WS_C2 = 449 * MiB;
constexpr size_t WS_END = 452 * MiB;
static_assert(WS_WD1 + (size_t)D * DFF * 2 <= WS_H && WS_O + (size_t)MA * D * 2 <= WS_ACT && WS_H + (size_t)MP * D * 4 <= WS_HB && WS_HB + (size_t)MP * D * 2 <= WS_ACT && WS_ACT + (size_t)MP * DFF * 2 <= WS_LF, "ws map");
static_assert(WS_Q + (size_t)MA * D * 2 <= WS_K && WS_K + (size_t)MA * D * 2 <= WS_V && WS_V + (size_t)MA * D * 2 <= WS_LF, "ws map 2");
static_assert(WS_V - WS_K == WS_K - WS_Q && WS_LF + (size_t)M * 16 * 4 <= WS_C2 && WS_C2 + (size_t)128 * LPAD * 4 <= WS_END, "ws map 3");

constexpr int LDS_BYTES = 135168;
constexpr int LDSCTL_OFF = 131072;


__device__ __forceinline__ int lane_id_asm() { int l; asm volatile("v_mbcnt_lo_u32_b32 %0, -1, 0\n\tv_mbcnt_hi_u32_b32 %0, -1, %0" : "=v"(l)); return l; }
__device__ __forceinline__ void grid_bar(unsigned* ctr, unsigned target, int wave) {
    asm volatile("s_waitcnt vmcnt(0)" ::: "memory");
    __syncthreads();
    if (wave == 0 && lane_id_asm() == 0) {
        __builtin_amdgcn_fence(__ATOMIC_RELEASE, "agent");
        asm volatile("s_waitcnt vmcnt(0)" ::: "memory");
        __hip_atomic_fetch_add(ctr, 1u, __ATOMIC_RELAXED, __HIP_MEMORY_SCOPE_AGENT);
        while (__hip_atomic_load(ctr, __ATOMIC_RELAXED, __HIP_MEMORY_SCOPE_AGENT) < target) __builtin_amdgcn_s_sleep(2);
        __builtin_amdgcn_fence(__ATOMIC_ACQUIRE, "agent");
        asm volatile("s_waitcnt vmcnt(0)" ::: "memory");
    }
    __syncthreads();
}

namespace pg8 {
constexpr int BM = 256, BK = 64, HALF = 128, HTB = HALF * BK * 2, NXCD = 8, WGM = 8;
__host__ __device__ __forceinline__ int lds_byte(int r, int c) { const int st = (r >> 4) * 2 + (c >> 5), rr = r & 15, cc = c & 31, ob = rr * 64 + cc * 2; return st * 1024 + (ob ^ (((ob >> 9) & 1) << 5)); }
__host__ __device__ __forceinline__ void stage_rc(int b, int& R, int& C) { const int st = b / 1024, sb = b % 1024, swz = sb ^ (((sb >> 9) & 1) << 5); R = (st >> 1) * 16 + swz / 64; C = (st & 1) * 32 + (swz % 64) / 2; }
__host__ __device__ __forceinline__ int perm32(int rho) { const int n = rho >> 4, i = rho & 15; return 8 * (i >> 2) + 4 * n + (i & 3); }

struct Unit { int pm, pn; };
struct Gemm { const bf16_t* A; const bf16_t* Bt; int lda, ldb, K, a_pn_bytes; };

struct StaticOrder {
    int nM, nN, nwg, G, c;
    __device__ void init(int M_, int N_, int G_, int c_) { nM = M_ / BM; nN = N_ / BM; nwg = nM * nN; G = G_; c = c_; }
    __device__ bool next(int i, Unit& u) const {
        const long L = (long)i * G + c; if (L >= nwg) return false;
        int wgid = (int)L; { const int q = nwg / NXCD, r = nwg % NXCD, xcd = wgid % NXCD, off = wgid / NXCD; wgid = (xcd < r ? xcd * (q + 1) : r * (q + 1) + (xcd - r) * q) + off; }
        const int nig = WGM * nN, gid = wgid / nig, fm = gid * WGM, gsz = (nM - fm) < WGM ? (nM - fm) : WGM;
        u.pm = fm + ((wgid % nig) % gsz); u.pn = (wgid % nig) / gsz; return true;
    }
};

template <class Epi, class Sched, bool ALIGN_EPI>
__device__ __forceinline__ void gemm_phase(LAS unsigned char* lds, const Gemm g, const Sched& S, const Epi& E, const int wid) {
    const int lane = lane_id_asm(), tid = wid * 64 + lane;
    const int wr = wid >> 2, wc = wid & 3, fr = lane & 15, fq = lane >> 4;
    const int nt = g.K / BK;
    unsigned voffA[2], voffB[2];
#pragma unroll
    for (int i = 0; i < 2; ++i) { int R, C; stage_rc(tid * 16 + i * 8192, R, C); const int Rb = (R & ~31) + perm32(R & 31);
        voffA[i] = (unsigned)(R * g.lda + C) * 2u; voffB[i] = (unsigned)(Rb * g.ldb + C) * 2u; }
    const size_t kstep = (size_t)(BK * 2);
    const size_t hA = (size_t)HALF * g.lda * 2, hB = (size_t)HALF * g.ldb * 2, tA = 2 * hA, tB = 2 * hB;
    const unsigned ldsw = (unsigned)wid * 1024u;
    const int aoff = lds_byte(wr * 64 + fr, fq * 8), boff = lds_byte(wc * 32 + fr, fq * 8);
#define PG8_SA(b, h) (((b) * 2 + (h)) * HTB)
#define PG8_SB(b, h) ((4 + (b) * 2 + (h)) * HTB)
#define PG8_STAGE(bufoff, gbase, voff) do { _Pragma("unroll") for (int _i = 0; _i < 2; ++_i) \
        __builtin_amdgcn_global_load_lds((const unsigned*)((const char*)(gbase) + (voff)[_i]), (LAS unsigned*)(lds + (bufoff) + ldsw + _i * 8192), 16, 0, 0); } while (0)
#define PG8_LDA(dst, b, h) do { _Pragma("unroll") for (int m = 0; m < 4; ++m) _Pragma("unroll") for (int k = 0; k < 2; ++k) dst[m][k] = *(const LAS bf16x8*)(lds + PG8_SA(b, h) + aoff + m * 2048 + k * 1024); } while (0)
#define PG8_LDB(dst, b, h) do { _Pragma("unroll") for (int n = 0; n < 2; ++n) _Pragma("unroll") for (int k = 0; k < 2; ++k) dst[n][k] = *(const LAS bf16x8*)(lds + PG8_SB(b, h) + boff + n * 2048 + k * 1024); } while (0)
#define PG8_MMA(ai, bj, At, Bt) do { __builtin_amdgcn_s_setprio(1); _Pragma("unroll") for (int m = 0; m < 4; ++m) _Pragma("unroll") for (int n = 0; n < 2; ++n) _Pragma("unroll") for (int k = 0; k < 2; ++k) \
        acc[ai][bj][m][n] = __builtin_amdgcn_mfma_f32_16x16x32_bf16(Bt[n][k], At[m][k], acc[ai][bj][m][n], 0, 0, 0); __builtin_amdgcn_s_setprio(0); } while (0)
#define PG8_WAIT_V(n) asm volatile("s_waitcnt vmcnt(" #n ")" ::: "memory")
#define PG8_WAIT_L(n) asm volatile("s_waitcnt lgkmcnt(" #n ")" ::: "memory")
#define PG8_BAR __builtin_amdgcn_s_barrier()
#define PG8_SCHED __builtin_amdgcn_sched_barrier(0)
    Unit cur, nxt; int ui = 0;
    if (!S.next(0, cur)) return;
    f32x4 acc[2][2][4][2];
#pragma unroll
    for (int a = 0; a < 2; ++a)
#pragma unroll
        for (int b = 0; b < 2; ++b)
#pragma unroll
            for (int m = 0; m < 4; ++m)
#pragma unroll
                for (int n = 0; n < 2; ++n) acc[a][b][m][n] = (f32x4){0.f, 0.f, 0.f, 0.f};
    bf16x8 At[4][2], B0[2][2], B1[2][2];
    const char* cA = (const char*)g.A + (size_t)cur.pm * tA + (size_t)cur.pn * g.a_pn_bytes; const char* cB = (const char*)g.Bt + (size_t)cur.pn * tB;
    PG8_STAGE(PG8_SB(0, 0), cB, voffB); PG8_STAGE(PG8_SB(0, 1), cB + hB, voffB); PG8_STAGE(PG8_SA(0, 0), cA, voffA); PG8_STAGE(PG8_SA(0, 1), cA + hA, voffA);
    if (wr == 1) PG8_BAR;
    PG8_WAIT_V(2); PG8_BAR;
    PG8_STAGE(PG8_SB(1, 0), cB + kstep, voffB); PG8_STAGE(PG8_SA(1, 0), cA + kstep, voffA); PG8_STAGE(PG8_SB(1, 1), cB + hB + kstep, voffB);
    PG8_WAIT_V(6); PG8_BAR;
    for (;;) {
        const bool has_next = S.next(ui + 1, nxt);
        const char* nA = has_next ? (const char*)g.A + (size_t)nxt.pm * tA + (size_t)nxt.pn * g.a_pn_bytes : cA; const char* nB = has_next ? (const char*)g.Bt + (size_t)nxt.pn * tB : cB;
        for (int t = 0; t < nt; t += 2) {
            const bool last = (t == nt - 2);
            const char* a1 = cA + (size_t)(t + 1) * kstep;
            const char* a2 = last ? nA : cA + (size_t)(t + 2) * kstep; const char* b2 = last ? nB : cB + (size_t)(t + 2) * kstep;
            const char* a3 = a2 + kstep; const char* b3 = b2 + kstep;
            PG8_LDB(B0, 0, 0); PG8_LDB(B1, 0, 1); PG8_SCHED; PG8_LDA(At, 0, 0); PG8_STAGE(PG8_SA(1, 1), a1 + hA, voffA);
            PG8_WAIT_V(8); PG8_WAIT_L(0); PG8_BAR; PG8_MMA(0, 0, At, B0); PG8_MMA(0, 1, At, B1); PG8_BAR; PG8_SCHED;
            PG8_LDA(At, 0, 1); PG8_STAGE(PG8_SB(0, 0), b2, voffB); PG8_STAGE(PG8_SB(0, 1), b2 + hB, voffB); PG8_STAGE(PG8_SA(0, 0), a2, voffA);
            PG8_WAIT_V(8); PG8_WAIT_L(0); PG8_BAR; PG8_MMA(1, 0, At, B0); PG8_MMA(1, 1, At, B1); PG8_BAR; PG8_SCHED;
            PG8_LDB(B0, 1, 0); PG8_LDB(B1, 1, 1); PG8_SCHED; PG8_LDA(At, 1, 0); PG8_STAGE(PG8_SA(0, 1), a2 + hA, voffA);
            PG8_WAIT_V(8); PG8_WAIT_L(0); PG8_BAR; PG8_MMA(0, 0, At, B0); PG8_MMA(0, 1, At, B1); PG8_BAR; PG8_SCHED;
            PG8_LDA(At, 1, 1); PG8_STAGE(PG8_SB(1, 0), b3, voffB); PG8_STAGE(PG8_SB(1, 1), b3 + hB, voffB); PG8_STAGE(PG8_SA(1, 0), a3, voffA);
            PG8_WAIT_V(8); PG8_WAIT_L(0); PG8_BAR; PG8_MMA(1, 0, At, B0); PG8_MMA(1, 1, At, B1); PG8_BAR; PG8_SCHED;
        }
        if constexpr (ALIGN_EPI) { if (wr == 0) PG8_BAR; }
        E(acc, cur, wr, wc, fr, fq);
        if (!has_next) break;
#pragma unroll
        for (int a = 0; a < 2; ++a)
#pragma unroll
            for (int b = 0; b < 2; ++b)
#pragma unroll
                for (int m = 0; m < 4; ++m)
#pragma unroll
                    for (int n = 0; n < 2; ++n) acc[a][b][m][n] = (f32x4){0.f, 0.f, 0.f, 0.f};
        cur = nxt; cA = nA; cB = nB; ++ui;
        if constexpr (ALIGN_EPI) { if (wr == 1) PG8_BAR; }
    }
    PG8_WAIT_V(0);
    if constexpr (!ALIGN_EPI) { if (wr == 0) PG8_BAR; }
    PG8_BAR;
#undef PG8_SA
#undef PG8_SB
#undef PG8_STAGE
#undef PG8_LDA
#undef PG8_LDB
#undef PG8_MMA
#undef PG8_WAIT_V
#undef PG8_WAIT_L
#undef PG8_BAR
#undef PG8_SCHED
}

__device__ __forceinline__ unsigned cvt_pk_bf16(float lo, float hi) { f32x2 v = {lo, hi}; bf16x2_t b = __builtin_convertvector(v, bf16x2_t); return __builtin_bit_cast(unsigned, b); }
__device__ __forceinline__ float silu_f(float x) { return x * __builtin_amdgcn_rcpf(1.0f + __builtin_amdgcn_exp2f(-LOG2E * x)); }

struct EpiSwiGLU {
    bf16_t* O;
    __device__ __forceinline__ void operator()(const f32x4 (&acc)[2][2][4][2], const Unit& u, int wr, int wc, int fr, int fq) const {
        const int row0 = u.pm * BM + wr * 64 + fr, col0 = u.pn * 128 + wc * 32 + 8 * fq;
#pragma unroll
        for (int ai = 0; ai < 2; ++ai)
#pragma unroll
            for (int m = 0; m < 4; ++m) {
                bf16_t* rowp = O + (size_t)(row0 + ai * HALF + m * 16) * DFF + col0;
                const f32x4 g0 = acc[ai][0][m][0], g1 = acc[ai][0][m][1], u0 = acc[ai][1][m][0], u1 = acc[ai][1][m][1];
                u32x4 w;
                w.x = cvt_pk_bf16(silu_f(g0[0]) * u0[0], silu_f(g0[1]) * u0[1]); w.y = cvt_pk_bf16(silu_f(g0[2]) * u0[2], silu_f(g0[3]) * u0[3]);
                w.z = cvt_pk_bf16(silu_f(g1[0]) * u1[0], silu_f(g1[1]) * u1[1]); w.w = cvt_pk_bf16(silu_f(g1[2]) * u1[2], silu_f(g1[3]) * u1[3]);
                *(u32x4*)rowp = w;
                asm volatile("" ::: "memory");
            }
    }
};
struct EpiResid {
    float* H;
    __device__ __forceinline__ void operator()(const f32x4 (&acc)[2][2][4][2], const Unit& u, int wr, int wc, int fr, int fq) const {
        const int row0 = u.pm * BM + wr * 64 + fr, col0 = u.pn * BM + wc * 32 + 8 * fq;
#pragma unroll
        for (int ai = 0; ai < 2; ++ai)
#pragma unroll
            for (int m = 0; m < 4; ++m) {
                const int row = row0 + ai * HALF + m * 16;
                if (row < M) {
                    float* rowp = H + (size_t)row * D + col0;
#pragma unroll
                    for (int bj = 0; bj < 2; ++bj)
#pragma unroll
                        for (int n = 0; n < 2; ++n) { f32x4* p = (f32x4*)(rowp + bj * HALF + 4 * n); const f32x4 v = *p; *p = v * ALPHA + acc[ai][bj][m][n]; }
                }
            }
    }
};
struct EpiOutProj {
    float* H;
    __device__ __forceinline__ void operator()(const f32x4 (&acc)[2][2][4][2], const Unit& u, int wr, int wc, int fr, int fq) const {
        const int b = u.pm / 17; const int minrow = (u.pm - b * 17 == 0) ? PADF : 0;
        const int lrow0 = wr * 64 + fr, col0 = u.pn * BM + wc * 32 + 8 * fq;
        float* base = H + ((size_t)(u.pm * BM) - (size_t)(PADF * (b + 1))) * D + col0;
#pragma unroll
        for (int ai = 0; ai < 2; ++ai)
#pragma unroll
            for (int m = 0; m < 4; ++m) {
                const int lrow = lrow0 + ai * HALF + m * 16;
                if (lrow >= minrow) {
                    float* rowp = base + (size_t)lrow * D;
#pragma unroll
                    for (int bj = 0; bj < 2; ++bj)
#pragma unroll
                        for (int n = 0; n < 2; ++n) { f32x4* p = (f32x4*)(rowp + bj * HALF + 4 * n); const f32x4 v = *p; *p = v * ALPHA + acc[ai][bj][m][n]; }
                }
                asm volatile("" ::: "memory");
            }
    }
};
struct EpiPool {
    const float* x; const float* meta; const float* scale; float* H;
    __device__ __forceinline__ void operator()(const f32x4 (&acc)[2][2][4][2], const Unit& u, int wr, int wc, int fr, int fq) const {
        const int row0 = u.pm * BM + wr * 64 + fr, col0 = u.pn * BM + wc * 32 + 8 * fq;
        const int blo = (u.pm * BM) / LSEQ, bound = (blo + 1) * LSEQ;
#pragma unroll
        for (int ai = 0; ai < 2; ++ai)
#pragma unroll
            for (int m = 0; m < 4; ++m) {
                const int row = row0 + ai * HALF + m * 16;
                if (row < M) {
                    const int b = blo + (row >= bound ? 1 : 0), p = row - b * LSEQ;
                    const float* src = (p < NMETA ? meta + (size_t)p * D : x + (size_t)(row - NMETA * (b + 1)) * D) + col0;
                    float* rowp = H + (size_t)row * D + col0;
#pragma unroll
                    for (int bj = 0; bj < 2; ++bj)
#pragma unroll
                        for (int n = 0; n < 2; ++n) { const f32x4 v = *(const f32x4*)(src + bj * HALF + 4 * n); const f32x4 sc = *(const f32x4*)(scale + col0 + bj * HALF + 4 * n);
                            *(f32x4*)(rowp + bj * HALF + 4 * n) = v * ALPHA + acc[ai][bj][m][n] * sc; }
                }
                asm volatile("" ::: "memory");
            }
    }
};
struct EpiQKV {
    bf16_t* QKV; float* LF;
    __device__ __forceinline__ void operator()(const f32x4 (&acc)[2][2][4][2], const Unit& u, int wr, int wc, int fr, int fq) const {
        const int row0 = u.pm * BM + wr * 64 + fr; const int t = u.pn >> 2;
        const int blo = (u.pm * BM) / LSEQ, bound = (blo + 1) * LSEQ;
        if (t < 3) {
            bf16_t* base = QKV + (size_t)t * ((WS_K - WS_Q) / 2); const float sc = (t == 0) ? QSCALE : 1.0f;
            const int col0 = (u.pn & 3) * BM + wc * 32 + 8 * fq;
#pragma unroll
            for (int ai = 0; ai < 2; ++ai)
#pragma unroll
                for (int m = 0; m < 4; ++m) {
                    const int row = row0 + ai * HALF + m * 16;
                    if (row < M) {
                        const int prow = row + PADF * (blo + 1) + (row >= bound ? PADF : 0);
                        bf16_t* rowp = base + (size_t)prow * D + col0;
#pragma unroll
                        for (int bj = 0; bj < 2; ++bj) { const f32x4 v0 = acc[ai][bj][m][0] * sc, v1 = acc[ai][bj][m][1] * sc;
                            u32x4 w; w.x = cvt_pk_bf16(v0[0], v0[1]); w.y = cvt_pk_bf16(v0[2], v0[3]); w.z = cvt_pk_bf16(v1[0], v1[1]); w.w = cvt_pk_bf16(v1[2], v1[3]);
                            *(u32x4*)(rowp + bj * HALF) = w; }
                    }
                    asm volatile("" ::: "memory");
                }
        } else if (wc == 0 && fq < 2) {
#pragma unroll
            for (int ai = 0; ai < 2; ++ai)
#pragma unroll
                for (int m = 0; m < 4; ++m) {
                    const int row = row0 + ai * HALF + m * 16;
                    if (row < M) {
#pragma unroll
                        for (int n = 0; n < 2; ++n) *(f32x4*)(LF + (size_t)row * 16 + 8 * fq + 4 * n) = acc[ai][0][m][n];
                    }
                }
        }
    }
};
}

__device__ __forceinline__ float wave_sum(float v) {
#pragma unroll
    for (int o = 1; o < 64; o <<= 1) v += __shfl_xor(v, o);
    return v;
}
__device__ __forceinline__ unsigned pk2(float lo, float hi) { return pg8::cvt_pk_bf16(lo, hi); }

__device__ __forceinline__ void transpose_item(const float* W, int ldw, int k0, int n0, int n_valid, bf16_t* WT, int ldwt, int dst_row0, LAS float* scr, int lane) {
#pragma unroll 8
    for (int i = 0; i < 32; ++i) { const int kk = 2 * i + (lane >> 5); const int n = n0 + (lane & 31); scr[kk * 33 + (lane & 31)] = (n < n_valid) ? W[(size_t)(k0 + kk) * ldw + n] : 0.f; }
    asm volatile("s_waitcnt lgkmcnt(0)" ::: "memory");
    const int c = lane & 7;
#pragma unroll
    for (int j = 0; j < 4; ++j) { const int n = (lane >> 3) + 8 * j; const LAS float* s = scr + (8 * c) * 33 + n;
        u32x4 o; o.x = pk2(s[0 * 33], s[1 * 33]); o.y = pk2(s[2 * 33], s[3 * 33]); o.z = pk2(s[4 * 33], s[5 * 33]); o.w = pk2(s[6 * 33], s[7 * 33]);
        *(u32x4*)(WT + (size_t)(dst_row0 + n) * ldwt + k0 + 8 * c) = o; }
    asm volatile("s_waitcnt lgkmcnt(0)" ::: "memory");
}

struct Args {
    const float* x; const float* meta; const float* pool_w; const float* pool_scale; const float* w_in; const float* b_f; const float* w_o;
    const float* w_gate; const float* w_up; const float* w_down; const float* ln_g; const float* ln_b;
    float* out; unsigned char* ws;
};

__device__ __forceinline__ void phase_prologue(const Args& a, LAS unsigned char* lds, int gw, int NGW, int wave, int lane) {
    unsigned char* ws = a.ws;
    LAS float* scr = (LAS float*)(lds + wave * 16384);
    constexpr int I_POOL = 4 * 4 * 8;
    constexpr int I_GU = 16 * 88;
    constexpr int I_DN = 44 * 32;
    constexpr int I_IN = 16 * 104;
    constexpr int I_O = 16 * 32;
    constexpr int NITEMS = I_POOL + 4 * I_GU + 2 * I_DN + I_IN + I_O;
    for (int it = gw; it < NITEMS; it += NGW) {
        int r = it;
        if (r < I_POOL) { const int g = r / 32, rr = r % 32, kb = rr / 8, nb = rr % 8;
            transpose_item(a.pool_w + (size_t)g * 65536, 256, 64 * kb, 32 * nb, 256, (bf16_t*)(ws + WS_WPOOL), 256, g * 256 + 32 * nb, scr, lane); continue; }
        r -= I_POOL;
        if (r < 4 * I_GU) { const int which = r / I_GU, rr = r % I_GU, layer = which >> 1, up = which & 1, kb = rr / 88, nb = rr % 88, n0 = 32 * nb;
            const float* W = (up ? a.w_up : a.w_gate) + (size_t)layer * D * DFF;
            bf16_t* WT = (bf16_t*)(ws + (layer ? WS_WGU1 : WS_WGU0));
            transpose_item(W, DFF, 64 * kb, n0, DFF, WT, D, (n0 / 128) * 256 + up * 128 + (n0 % 128), scr, lane); continue; }
        r -= 4 * I_GU;
        if (r < 2 * I_DN) { const int layer = r / I_DN, rr = r % I_DN, kb = rr / 32, nb = rr % 32;
            transpose_item(a.w_down + (size_t)layer * DFF * D, D, 64 * kb, 32 * nb, D, (bf16_t*)(ws + (layer ? WS_WD1 : WS_WD0)), DFF, 32 * nb, scr, lane); continue; }
        r -= 2 * I_DN;
        if (r < I_IN) { const int kb = r / 104, nb = r % 104;
            transpose_item(a.w_in, 3 * D + NH, 64 * kb, 32 * nb, 3 * D + NH, (bf16_t*)(ws + WS_WIN), D, 32 * nb, scr, lane); continue; }
        r -= I_IN;
        { const int kb = r / 32, nb = r % 32; transpose_item(a.w_o, D, 64 * kb, 32 * nb, D, (bf16_t*)(ws + WS_WO), D, 32 * nb, scr, lane); }
    }
    bf16_t* Y = (bf16_t*)(ws + WS_ACT);
    constexpr int CH_PER_B = LSEQ / 16;
    for (int ck = gw; ck < BATCH * CH_PER_B; ck += NGW) {
        const int b = ck / CH_PER_B, r0 = (ck % CH_PER_B) * 16;
        f32x4 S[4];
#pragma unroll
        for (int g = 0; g < 4; ++g) S[g] = (f32x4){0.f, 0.f, 0.f, 0.f};
#define H0ROW(p) (((p) < NMETA) ? a.meta + (size_t)(p) * D : a.x + ((size_t)b * SEQ + ((p) - NMETA)) * D)
#pragma unroll
        for (int g = 0; g < 4; ++g) { const int w = 2 << g;
            for (int s = r0 - w + 1; s < r0; ++s) if (s >= 0) S[g] += *(const f32x4*)(H0ROW(s) + g * 256 + lane * 4); }
        for (int p = r0; p < r0 + 16; ++p) {
            const float* cur = H0ROW(p);
#pragma unroll
            for (int g = 0; g < 4; ++g) { const int w = 2 << g;
                const f32x4 xv = *(const f32x4*)(cur + g * 256 + lane * 4);
                S[g] += xv;
                const int cnt = (p + 1 < w) ? (p + 1) : w;
                const f32x4 y = S[g] * (1.0f / (float)cnt) - xv;
                u32x2 o; o.x = pk2(y[0], y[1]); o.y = pk2(y[2], y[3]);
                *(u32x2*)(Y + (size_t)(b * LSEQ + p) * D + g * 256 + lane * 4) = o;
                const int sub = p - w + 1;
                if (sub >= 0) S[g] -= *(const f32x4*)(H0ROW(sub) + g * 256 + lane * 4);
            }
        }
#undef H0ROW
    }
}

template <bool FINAL>
__device__ __forceinline__ void phase_ln(const Args& a, const float* g, const float* bta, int gw, int NGW, int lane) {
    float* H = (float*)(a.ws + WS_H); bf16_t* HB = (bf16_t*)(a.ws + WS_HB);
    f32x4 gv[4], bv[4];
#pragma unroll
    for (int j = 0; j < 4; ++j) { gv[j] = *((const f32x4*)g + lane + 64 * j); bv[j] = *((const f32x4*)bta + lane + 64 * j); }
    for (int m = gw; m < M; m += NGW) {
        f32x4* xr = (f32x4*)(H + (size_t)m * D) + lane;
        f32x4 v[4]; float s = 0.f;
#pragma unroll
        for (int j = 0; j < 4; ++j) { v[j] = xr[64 * j]; s += (v[j].x + v[j].y) + (v[j].z + v[j].w); }
        const float mean = wave_sum(s) * (1.f / D); float s2 = 0.f;
#pragma unroll
        for (int j = 0; j < 4; ++j) { v[j] = v[j] - mean; s2 += (v[j].x * v[j].x + v[j].y * v[j].y) + (v[j].z * v[j].z + v[j].w * v[j].w); }
        const float rstd = 1.f / sqrtf(wave_sum(s2) * (1.f / D) + LN_EPS);
        if (FINAL) {
            const int b = m / LSEQ, p = m - b * LSEQ;
            if (p >= NMETA) { f32x4* o = (f32x4*)(a.out + ((size_t)b * SEQ + (p - NMETA)) * D) + lane;
#pragma unroll
                for (int j = 0; j < 4; ++j) o[64 * j] = v[j] * rstd * gv[j] + bv[j]; }
        } else {
            u32x2* o8 = (u32x2*)(HB + (size_t)m * D) + lane;
#pragma unroll
            for (int j = 0; j < 4; ++j) { const f32x4 y = v[j] * rstd * gv[j] + bv[j]; xr[64 * j] = y; u32x2 w; w.x = pk2(y.x, y.y); w.y = pk2(y.z, y.w); o8[64 * j] = w; }
        }
    }
}

__device__ __forceinline__ float log2_sigmoid(float xx) { return -LOG2E * (fmaxf(-xx, 0.f) + log1pf(__expf(-fabsf(xx)))); }
__device__ __forceinline__ void phase_cumsum(const Args& a, int gw, int NGW, int lane) {
    const float* LF = (const float*)(a.ws + WS_LF); float* C2 = (float*)(a.ws + WS_C2);
    for (int bh = gw; bh < BATCH * NH; bh += NGW) {
        const int b = bh >> 4, h = bh & 15;
        const float bias = a.b_f[h];
        const int p0 = lane * 65; const int p1 = (p0 + 65 < LSEQ) ? p0 + 65 : LSEQ;
        float sum = 0.f;
        for (int p = p0; p < p1; ++p) sum += log2_sigmoid(LF[(size_t)(b * LSEQ + p) * 16 + h] + bias);
        float incl = sum;
#pragma unroll
        for (int off = 1; off < 64; off <<= 1) { const float t = __shfl_up(incl, off); if (lane >= off) incl += t; }
        float run = incl - sum;
        for (int p = p0; p < p1; ++p) { run += log2_sigmoid(LF[(size_t)(b * LSEQ + p) * 16 + h] + bias); C2[(size_t)bh * LPAD + PADF + p] = run; }
        for (int i = lane; i < PADF; i += 64) C2[(size_t)bh * LPAD + i] = 0.f;
    }
    { unsigned* KMAX = (unsigned*)(a.ws + WS_CTL) + 256; const bf16_t* Kb = (const bf16_t*)(a.ws + WS_K);
      for (int it = gw; it < BATCH * NH * 65; it += NGW) {
          const int bh = it / 65, t = 3 + it % 65, b = bh >> 4, h = bh & 15; const int pp = t * 64 + lane;
          float n2 = 0.f;
          if (pp >= PADF) { const u32x4* kp = (const u32x4*)(Kb + ((size_t)b * LPAD + pp) * D + h * HD);
#pragma unroll
              for (int c = 0; c < 8; ++c) { const u32x4 w = kp[c];
#pragma unroll
                  for (int j = 0; j < 4; ++j) { const float lo = __uint_as_float(w[j] << 16), hi = __uint_as_float(w[j] & 0xffff0000u); n2 += lo * lo + hi * hi; } } }
#pragma unroll
          for (int o = 1; o < 64; o <<= 1) n2 = fmaxf(n2, __shfl_xor(n2, o));
          if (lane == 0) atomicMax(KMAX + bh, __float_as_uint(sqrtf(n2)));
      } }
    for (int r = gw; r < 3 * BATCH * PADF; r += NGW) {
        const int t = r / (BATCH * PADF), rr = r % (BATCH * PADF), b = rr / PADF, pp = rr % PADF;
        bf16_t* base = (bf16_t*)(a.ws + (t == 0 ? WS_Q : t == 1 ? WS_K : WS_V)) + (size_t)(b * LPAD + pp) * D;
        u32x4 z = {0u, 0u, 0u, 0u};
        *((u32x4*)base + lane) = z; *((u32x4*)base + 64 + lane) = z;
    }
}

namespace att {
constexpr int RSK = 144, RSV = 192, KBUF = 64 * RSK, VBUF = 64 * RSV;
constexpr int OFF_K = 0, OFF_V = 2 * KBUF, OFF_C = OFF_V + 2 * VBUF, OFF_W = OFF_C + 2 * 256, TOTAL = OFF_W + 8 * 256;
static_assert(TOTAL <= 131072, "attention LDS");
constexpr int NQB = LPAD / 256;
constexpr int NUNITS = BATCH * NH * NQB;
__device__ __forceinline__ int crow(int r, int hi) { return (r & 3) + 8 * (r >> 2) + 4 * hi; }

__device__ __forceinline__ void attn_unit(int bh, int qb, const bf16_t* Q, const bf16_t* K, const bf16_t* V, bf16_t* O, const float* C2, const unsigned* KMAXp, LAS unsigned char* lds, const int wid) {
    const int lane = lane_id_asm(), tid = wid * 64 + lane, r32 = lane & 31, hi = lane >> 5;
    const int b = bh >> 4, h = bh & 15;
    const size_t rowbase = (size_t)b * LPAD;
    const int qw0 = qb * 256 + wid * 32, myq = qw0 + r32;
    bf16x8 qr[4];
    { const bf16_t* Qp = Q + (rowbase + myq) * D + h * HD;
#pragma unroll
      for (int d0 = 0; d0 < 4; ++d0) qr[d0] = *(const bf16x8*)(Qp + d0 * 16 + hi * 8); }
    const float cq = C2[(size_t)bh * LPAD + myq];
    float m_run = NEGBIG, l_run = 0.f;
    f32x16 o[2];
#pragma unroll
    for (int r = 0; r < 16; ++r) { o[0][r] = 0.f; o[1][r] = 0.f; }
    const int thi = 4 * qb + 3;
    int t_lo;
    { float qn2 = 0.f;
#pragma unroll
      for (int d0 = 0; d0 < 4; ++d0)
#pragma unroll
          for (int j = 0; j < 8; ++j) { const float v = __uint_as_float(((unsigned)(unsigned short)qr[d0][j]) << 16); qn2 += v * v; }
      qn2 += __shfl_xor(qn2, 32);
#pragma unroll
      for (int o = 1; o < 32; o <<= 1) qn2 = fmaxf(qn2, __shfl_xor(qn2, o));
      LAS float* qsh = (LAS float*)(lds + OFF_W);
      if (lane == 0) qsh[wid * 64] = qn2;
      __syncthreads();
      float qm = qsh[0];
#pragma unroll
      for (int w = 1; w < 8; ++w) qm = fmaxf(qm, qsh[w * 64]);
      const float kmax = __uint_as_float(((const unsigned*)KMAXp)[bh]);
      const float X = C2[(size_t)bh * LPAD + qb * 256] + 2.02f * sqrtf(qm) * kmax + 152.0f;
      int cand = thi;
      for (int t = 3 + lane; t <= thi; t += 64) if (C2[(size_t)bh * LPAD + t * 64 + 63] <= X) cand = min(cand, t);
#pragma unroll
      for (int o = 1; o < 64; o <<= 1) cand = min(cand, __shfl_xor(cand, o));
      t_lo = __builtin_amdgcn_readfirstlane(cand);
      __syncthreads(); }
    const int srow = tid >> 3, sch = tid & 7;
    const bf16_t* gK = K + (rowbase + srow) * D + h * HD + sch * 8;
    const bf16_t* gV = V + (rowbase + srow) * D + h * HD + sch * 8;
    const float* gC = C2 + (size_t)bh * LPAD;
    LAS float* wsf = (LAS float*)(lds + OFF_W) + wid * 64;
    { const u32x4 kv = *(const u32x4*)(gK + (size_t)thi * 64 * D), vv = *(const u32x4*)(gV + (size_t)thi * 64 * D);
      *(LAS u32x4*)(lds + OFF_K + srow * RSK + sch * 16) = kv; *(LAS u32x4*)(lds + OFF_V + srow * RSV + sch * 16) = vv;
      if (tid < 64) *(LAS float*)(lds + OFF_C + tid * 4) = gC[thi * 64 + tid]; }
    __syncthreads();
    const int i16 = lane & 15, q4 = i16 >> 2, p4 = i16 & 3, blk = (lane >> 4) & 1;
    const int vtr_off = (4 * hi + q4) * RSV + (16 * blk + 4 * p4) * 2;
    int it = 0;
    for (int t = thi; t >= t_lo; --t, ++it) {
        const int buf = it & 1;
        u32x4 kvn = {0u, 0u, 0u, 0u}, vvn = {0u, 0u, 0u, 0u}; float cn = 0.f;
        if (t > t_lo) { kvn = *(const u32x4*)(gK + (size_t)(t - 1) * 64 * D); vvn = *(const u32x4*)(gV + (size_t)(t - 1) * 64 * D); if (tid < 64) cn = gC[(t - 1) * 64 + tid]; }
        const int k0 = t * 64;
        if (k0 <= qw0 + 31) {
            const LAS unsigned char* Kb = lds + OFF_K + buf * KBUF; const LAS unsigned char* Vb = lds + OFF_V + buf * VBUF;
            const LAS float* ckp = (const LAS float*)(lds + OFF_C + buf * 256);
            f32x16 p0, p1;
#pragma unroll
            for (int r = 0; r < 16; ++r) { p0[r] = 0.f; p1[r] = 0.f; }
#pragma unroll
            for (int d0 = 0; d0 < 4; ++d0) {
                const bf16x8 a0 = *(const LAS bf16x8*)(Kb + r32 * RSK + (d0 * 16 + hi * 8) * 2);
                const bf16x8 a1 = *(const LAS bf16x8*)(Kb + (32 + r32) * RSK + (d0 * 16 + hi * 8) * 2);
                p0 = __builtin_amdgcn_mfma_f32_32x32x16_bf16(a0, qr[d0], p0, 0, 0, 0);
                p1 = __builtin_amdgcn_mfma_f32_32x32x16_bf16(a1, qr[d0], p1, 0, 0, 0);
            }
#pragma unroll
            for (int g = 0; g < 4; ++g) {
                const f32x4 c0 = *(const LAS f32x4*)(ckp + 8 * g + 4 * hi), c1 = *(const LAS f32x4*)(ckp + 32 + 8 * g + 4 * hi);
#pragma unroll
                for (int j = 0; j < 4; ++j) { p0[4 * g + j] += cq - c0[j]; p1[4 * g + j] += cq - c1[j]; }
            }
            if (t == 3 || k0 + 63 > qw0) {
#pragma unroll
                for (int r = 0; r < 16; ++r) { const int kv = k0 + crow(r, hi);
                    if (kv > myq || kv < PADF) p0[r] = NEGBIG;
                    if (kv + 32 > myq || kv + 32 < PADF) p1[r] = NEGBIG; }
            }
            float mx = fmaxf(p0[0], p1[0]);
#pragma unroll
            for (int r = 1; r < 16; ++r) mx = fmaxf(mx, fmaxf(p0[r], p1[r]));
            mx = fmaxf(mx, __shfl_xor(mx, 32));
            const float m_new = fmaxf(m_run, mx);
            if (__any(m_new > m_run)) {
                const float alpha = __builtin_amdgcn_exp2f(m_run - m_new);
                l_run *= alpha;
                if (hi == 0) wsf[r32] = alpha;
                asm volatile("s_waitcnt lgkmcnt(0)" ::: "memory");
#pragma unroll
                for (int g = 0; g < 4; ++g) { const f32x4 f = *(const LAS f32x4*)(wsf + 8 * g + 4 * hi);
#pragma unroll
                    for (int j = 0; j < 4; ++j) { o[0][4 * g + j] *= f[j]; o[1][4 * g + j] *= f[j]; } }
                asm volatile("s_waitcnt lgkmcnt(0)" ::: "memory");
                m_run = m_new;
            }
            float ls = 0.f;
#pragma unroll
            for (int r = 0; r < 16; ++r) { p0[r] = __builtin_amdgcn_exp2f(p0[r] - m_run); p1[r] = __builtin_amdgcn_exp2f(p1[r] - m_run); ls += p0[r] + p1[r]; }
            l_run += ls;
            bf16x8 pa[4];
#pragma unroll
            for (int s = 0; s < 4; ++s) { u32x4 w;
#pragma unroll
                for (int j = 0; j < 4; ++j) { const int r = 8 * (s & 1) + 2 * j; w[j] = (s < 2) ? pg8::cvt_pk_bf16(p0[r], p0[r + 1]) : pg8::cvt_pk_bf16(p1[r], p1[r + 1]); }
                pa[s] = __builtin_bit_cast(bf16x8, w); }
#pragma unroll
            for (int d0 = 0; d0 < 2; ++d0)
#pragma unroll
                for (int s = 0; s < 4; ++s) {
                    const LAS unsigned char* vp = Vb + vtr_off + (16 * s) * RSV + d0 * 64;
                    const s16x4 lo = __builtin_bit_cast(s16x4, __builtin_amdgcn_ds_read_tr16_b64_v4i16((LAS s16x4*)vp));
                    const s16x4 hh = __builtin_bit_cast(s16x4, __builtin_amdgcn_ds_read_tr16_b64_v4i16((LAS s16x4*)(vp + 8 * RSV)));
                    const bf16x8 vb = __builtin_shufflevector(lo, hh, 0, 1, 2, 3, 4, 5, 6, 7);
                    o[d0] = __builtin_amdgcn_mfma_f32_32x32x16_bf16(pa[s], vb, o[d0], 0, 0, 0);
                }
        }
        if (t > t_lo) {
            const int nb = buf ^ 1;
            *(LAS u32x4*)(lds + OFF_K + nb * KBUF + srow * RSK + sch * 16) = kvn; *(LAS u32x4*)(lds + OFF_V + nb * VBUF + srow * RSV + sch * 16) = vvn;
            if (tid < 64) *(LAS float*)(lds + OFF_C + nb * 256 + tid * 4) = cn;
        }
        __syncthreads();
    }
    float l_tot = l_run + __shfl_xor(l_run, 32);
    if (hi == 0) wsf[r32] = 1.0f / l_tot;
    asm volatile("s_waitcnt lgkmcnt(0)" ::: "memory");
    bf16_t* Op = O + (rowbase + qw0) * D + h * HD + r32;
#pragma unroll
    for (int g = 0; g < 4; ++g) { const f32x4 f = *(const LAS f32x4*)(wsf + 8 * g + 4 * hi);
#pragma unroll
        for (int j = 0; j < 4; ++j) { const int r = 4 * g + j; const int qrow = crow(r, hi);
            const unsigned w0 = pg8::cvt_pk_bf16(o[0][r] * f[j], 0.f), w1 = pg8::cvt_pk_bf16(o[1][r] * f[j], 0.f);
            Op[(size_t)qrow * D] = (bf16_t)(w0 & 0xffffu); Op[(size_t)qrow * D + 32] = (bf16_t)(w1 & 0xffffu); } }
    asm volatile("s_waitcnt lgkmcnt(0)" ::: "memory");
    __syncthreads();
}
}

__global__ void __launch_bounds__(512, 2) fwd_megakernel(Args a) {
    extern __shared__ __attribute__((aligned(16))) unsigned char lds_raw[];
    LAS unsigned char* lds = (LAS unsigned char*)lds_raw;
    const int wave = __builtin_amdgcn_readfirstlane(threadIdx.x >> 6);
    const int G = gridDim.x, bx = blockIdx.x;
    const int vcu = (G % 8 == 0) ? (bx % 8) * (G / 8) + bx / 8 : bx;
    const int gw = vcu * 8 + wave, NGW = G * 8;
    unsigned char* ws = a.ws;
    float* H = (float*)(ws + WS_H); bf16_t* HB = (bf16_t*)(ws + WS_HB); bf16_t* ACT = (bf16_t*)(ws + WS_ACT);
    unsigned* barctr = (unsigned*)(ws + WS_CTL) + 64; unsigned nbar = 0;
#define LANE() lane_id_asm()
#define GSYNC() do { ++nbar; grid_bar(barctr, nbar * (unsigned)G, wave); } while (0)

    phase_prologue(a, lds, gw, NGW, wave, LANE());
    cg::this_grid().sync();
    { pg8::Gemm g{ACT, (const bf16_t*)(ws + WS_WPOOL), D, 256, 256, 512}; pg8::StaticOrder S; S.init(MP, D, G, bx);
      pg8::EpiPool E{a.x, a.meta, a.pool_scale, H};
      pg8::gemm_phase<pg8::EpiPool, pg8::StaticOrder, true>(lds, g, S, E, wave); }
    GSYNC();
    phase_ln<false>(a, a.ln_g, a.ln_b, gw, NGW, LANE());
    GSYNC();
#define FFN_PHASES(layer) do { \
        { pg8::Gemm g{HB, (const bf16_t*)(ws + ((layer) ? WS_WGU1 : WS_WGU0)), D, D, D, 0}; pg8::StaticOrder S; S.init(MP, 2 * DFF, G, bx); \
          pg8::EpiSwiGLU E{ACT}; \
          pg8::gemm_phase<pg8::EpiSwiGLU, pg8::StaticOrder, true>(lds, g, S, E, wave); } \
        GSYNC(); \
        { pg8::Gemm g{ACT, (const bf16_t*)(ws + ((layer) ? WS_WD1 : WS_WD0)), DFF, DFF, DFF, 0}; pg8::StaticOrder S; S.init(MP, D, G, bx); \
          pg8::EpiResid E{H}; \
          pg8::gemm_phase<pg8::EpiResid, pg8::StaticOrder, true>(lds, g, S, E, wave); } \
        GSYNC(); } while (0)
    FFN_PHASES(0);
    phase_ln<false>(a, a.ln_g + D, a.ln_b + D, gw, NGW, LANE());
    GSYNC();
    { pg8::Gemm g{HB, (const bf16_t*)(ws + WS_WIN), D, D, D, 0}; pg8::StaticOrder S; S.init(MP, NIN, G, bx);
      pg8::EpiQKV E{(bf16_t*)(ws + WS_Q), (float*)(ws + WS_LF)};
      pg8::gemm_phase<pg8::EpiQKV, pg8::StaticOrder, true>(lds, g, S, E, wave); }
    GSYNC();
    phase_cumsum(a, gw, NGW, LANE());
    GSYNC();
#ifndef REP_ATT
#define REP_ATT 1
#endif
    for (int rep = 0; rep < REP_ATT; ++rep) { unsigned* ctr = (unsigned*)(ws + WS_CTL) + 128 * rep; LAS unsigned* sh = (LAS unsigned*)(lds + LDSCTL_OFF);
      for (;;) {
          if (wave == 0 && LANE() == 0) sh[0] = atomicAdd(ctr, 1u);
          __syncthreads();
          const unsigned idx = sh[0];
          __syncthreads();
          if (idx >= (unsigned)att::NUNITS) break;
          const int qb = att::NQB - 1 - (int)(idx / (BATCH * NH)), bh = (int)(idx % (BATCH * NH));
          att::attn_unit(bh, qb, (const bf16_t*)(ws + WS_Q), (const bf16_t*)(ws + WS_K), (const bf16_t*)(ws + WS_V), (bf16_t*)(ws + WS_O), (const float*)(ws + WS_C2), (const unsigned*)(ws + WS_CTL) + 256, lds, wave);
      } }
    GSYNC();
    { pg8::Gemm g{(const bf16_t*)(ws + WS_O), (const bf16_t*)(ws + WS_WO), D, D, D, 0}; pg8::StaticOrder S; S.init(MA, D, G, bx);
      pg8::EpiOutProj E{H};
      pg8::gemm_phase<pg8::EpiOutProj, pg8::StaticOrder, true>(lds, g, S, E, wave); }
    GSYNC();
    phase_ln<false>(a, a.ln_g + 2 * D, a.ln_b + 2 * D, gw, NGW, LANE());
    GSYNC();
    FFN_PHASES(1);
    phase_ln<true>(a, a.ln_g + 3 * D, a.ln_b + 3 * D, gw, NGW, LANE());
}

extern "C" void kernel_launch(void* const* d_in, const int* in_sizes, int n_in, void* d_out, int out_size, void* d_ws, size_t ws_size, hipStream_t stream) {
    static int grid = 0;
    if (grid == 0) {
        if (n_in != 12 || ws_size < WS_END) { fprintf(stderr, "kernel_launch: unexpected n_in %d / ws_size %zu\n", n_in, ws_size); grid = -1; return; }
        int dev = 0, cus = 0, per_cu = 0;
        hipGetDevice(&dev);
        hipDeviceGetAttribute(&cus, hipDeviceAttributeMultiprocessorCount, dev);
        hipFuncSetAttribute((const void*)fwd_megakernel, hipFuncAttributeMaxDynamicSharedMemorySize, LDS_BYTES);
        hipOccupancyMaxActiveBlocksPerMultiprocessor(&per_cu, (const void*)fwd_megakernel, 512, LDS_BYTES);
        if (per_cu < 1) { fprintf(stderr, "kernel_launch: occupancy query says %d blocks per CU\n", per_cu); grid = -1; return; }
        grid = cus;
    }
    if (grid < 0) return;
    hipMemsetAsync((char*)d_ws + WS_CTL, 0, 4096, stream);
    Args a{};
    a.x = (const float*)d_in[0]; a.meta = (const float*)d_in[1]; a.pool_w = (const float*)d_in[2]; a.pool_scale = (const float*)d_in[3];
    a.w_in = (const float*)d_in[4]; a.b_f = (const float*)d_in[5]; a.w_o = (const float*)d_in[6];
    a.w_gate = (const float*)d_in[7]; a.w_up = (const float*)d_in[8]; a.w_down = (const float*)d_in[9]; a.ln_g = (const float*)d_in[10]; a.ln_b = (const float*)d_in[11];
    a.out = (float*)d_out; a.ws = (unsigned char*)d_ws;
    void* args[] = {&a};
    hipError_t e = hipLaunchCooperativeKernel((const void*)fwd_megakernel, dim3(grid), dim3(512), args, LDS_BYTES, stream);
    if (e != hipSuccess) fprintf(stderr, "cooperative launch failed: %s (grid %d)\n", hipGetErrorString(e), grid);
}
```

```cpp
#include <hip/hip_runtime.h>
#include <hip/hip_cooperative_groups.h>
#include <cstdio>
#include <cstdint>
namespace cg = cooperative_groups;

#define LAS __attribute__((address_space(3)))
typedef unsigned short bf16_t;
typedef short bf16x8 __attribute__((ext_vector_type(8)));
typedef short s16x4 __attribute__((ext_vector_type(4)));
typedef float f32x4 __attribute__((ext_vector_type(4)));
typedef float f32x2 __attribute__((ext_vector_type(2)));
typedef float f32x16 __attribute__((ext_vector_type(16)));
typedef unsigned u32x4 __attribute__((ext_vector_type(4)));
typedef unsigned u32x2 __attribute__((ext_vector_type(2)));
typedef __bf16 bf16x2_t __attribute__((ext_vector_type(2)));

constexpr int BATCH = 8, SEQ = 4096, NMETA = 16, LSEQ = SEQ + NMETA;
constexpr int D = 1024, DFF = 2816, NH = 16, HD = 64;
constexpr int M = BATCH * LSEQ;
constexpr int MP = 33024;
constexpr int LPAD = 4352, PADF = 240;
constexpr int MA = BATCH * LPAD;
constexpr int NIN = 3328;
constexpr float ALPHA = 1.41421356237309515f;
constexpr float LN_EPS = 1e-5f;
constexpr float LOG2E = 1.4426950408889634f;
constexpr float QSCALE = 0.125f * LOG2E;
constexpr float NEGBIG = -1e30f;

constexpr size_t MiB = 1u << 20;
constexpr size_t WS_CTL = 0;
constexpr size_t WS_WPOOL = 1 * MiB, WS_WGU0 = 2 * MiB, WS_WD0 = 13 * MiB, WS_WIN = 19 * MiB, WS_WO = 26 * MiB, WS_WGU1 = 28 * MiB, WS_WD1 = 39 * MiB;
constexpr size_t WS_H = 45 * MiB;
constexpr size_t WS_HB = 174 * MiB;
constexpr size_t WS_O = WS_HB;
constexpr size_t WS_ACT = 242 * MiB;
constexpr size_t WS_Q = 242 * MiB, WS_K = 310 * MiB, WS_V = 378 * MiB;
constexpr size_t WS_LF = 446 * MiB;
constexpr size_t WS_C2 = 449 * MiB;
constexpr size_t WS_P = 452 * MiB;
constexpr size_t WS_END = 458 * MiB;
static_assert(WS_WD1 + (size_t)D * DFF * 2 <= WS_H && WS_O + (size_t)MA * D * 2 <= WS_ACT && WS_H + (size_t)MP * D * 4 <= WS_HB && WS_HB + (size_t)MP * D * 2 <= WS_ACT && WS_ACT + (size_t)MP * DFF * 2 <= WS_LF, "ws map");
static_assert(WS_Q + (size_t)MA * D * 2 <= WS_K && WS_K + (size_t)MA * D * 2 <= WS_V && WS_V + (size_t)MA * D * 2 <= WS_LF, "ws map 2");
static_assert(WS_V - WS_K == WS_K - WS_Q && WS_LF + (size_t)M * 16 * 4 <= WS_C2 && WS_C2 + (size_t)128 * LPAD * 4 <= WS_END, "ws map 3");

constexpr int LDS_BYTES = 135168;
constexpr int LDSCTL_OFF = 131072;


__device__ __forceinline__ int lane_id_asm() { int l; asm volatile("v_mbcnt_lo_u32_b32 %0, -1, 0\n\tv_mbcnt_hi_u32_b32 %0, -1, %0" : "=v"(l)); return l; }
__device__ __forceinline__ void grid_bar(unsigned* ctr, unsigned target, int wave) {
    asm volatile("s_waitcnt vmcnt(0)" ::: "memory");
    __syncthreads();
    if (wave == 0 && lane_id_asm() == 0) {
        __builtin_amdgcn_fence(__ATOMIC_RELEASE, "agent");
        asm volatile("s_waitcnt vmcnt(0)" ::: "memory");
        __hip_atomic_fetch_add(ctr, 1u, __ATOMIC_RELAXED, __HIP_MEMORY_SCOPE_AGENT);
        while (__hip_atomic_load(ctr, __ATOMIC_RELAXED, __HIP_MEMORY_SCOPE_AGENT) < target) __builtin_amdgcn_s_sleep(2);
        __builtin_amdgcn_fence(__ATOMIC_ACQUIRE, "agent");
        asm volatile("s_waitcnt vmcnt(0)" ::: "memory");
    }
    __syncthreads();
}

namespace pg8 {
constexpr int BM = 256, BK = 64, HALF = 128, HTB = HALF * BK * 2, NXCD = 8, WGM = 8;
__host__ __device__ __forceinline__ int lds_byte(int r, int c) { const int st = (r >> 4) * 2 + (c >> 5), rr = r & 15, cc = c & 31, ob = rr * 64 + cc * 2; return st * 1024 + (ob ^ (((ob >> 9) & 1) << 5)); }
__host__ __device__ __forceinline__ void stage_rc(int b, int& R, int& C) { const int st = b / 1024, sb = b % 1024, swz = sb ^ (((sb >> 9) & 1) << 5); R = (st >> 1) * 16 + swz / 64; C = (st & 1) * 32 + (swz % 64) / 2; }
__host__ __device__ __forceinline__ int perm32(int rho) { const int n = rho >> 4, i = rho & 15; return 8 * (i >> 2) + 4 * n + (i & 3); }

struct Unit { int pm, pn, koff; };
struct Gemm { const bf16_t* A; const bf16_t* Bt; int lda, ldb, K, a_pn_bytes, a_base, a_skip; };

struct StaticOrder {
    int nM, nN, nwg, G, c;
    __device__ void init(int M_, int N_, int G_, int c_) { nM = M_ / BM; nN = N_ / BM; nwg = nM * nN; G = G_; c = c_; }
    __device__ bool next(int i, Unit& u) const {
        const long L = (long)i * G + c; if (L >= nwg) return false;
        int wgid = (int)L; { const int q = nwg / NXCD, r = nwg % NXCD, xcd = wgid % NXCD, off = wgid / NXCD; wgid = (xcd < r ? xcd * (q + 1) : r * (q + 1) + (xcd - r) * q) + off; }
        const int nig = WGM * nN, gid = wgid / nig, fm = gid * WGM, gsz = (nM - fm) < WGM ? (nM - fm) : WGM;
        u.pm = fm + ((wgid % nig) % gsz); u.pn = (wgid % nig) / gsz; u.koff = 0; return true;
    }
};

struct TailKOrder {
    int pm_tail, nk, kchunk, c;
    __device__ bool next(int i, Unit& u) const { if (i > 0 || c >= 4 * nk) return false; u.pm = pm_tail; u.pn = c & 3; u.koff = (c >> 2) * kchunk * 2; return true; }
};
template <class Epi, class Sched, bool ALIGN_EPI>
__device__ __forceinline__ void gemm_phase(LAS unsigned char* lds, const Gemm g, const Sched& S, const Epi& E, const int wid) {
    const int lane = lane_id_asm(), tid = wid * 64 + lane;
    const int wr = wid >> 2, wc = wid & 3, fr = lane & 15, fq = lane >> 4;
    const int nt = g.K / BK;
    unsigned voffA[2], voffB[2];
#pragma unroll
    for (int i = 0; i < 2; ++i) { int R, C; stage_rc(tid * 16 + i * 8192, R, C); const int Rb = (R & ~31) + perm32(R & 31);
        voffA[i] = (unsigned)(R * g.lda + C) * 2u; voffB[i] = (unsigned)(Rb * g.ldb + C) * 2u; }
    const size_t kstep = (size_t)(BK * 2);
    const size_t hA = (size_t)HALF * g.lda * 2, hB = (size_t)HALF * g.ldb * 2, tB = 2 * hB;
    const unsigned ldsw = (unsigned)wid * 1024u;
    const int aoff = lds_byte(wr * 64 + fr, fq * 8), boff = lds_byte(wc * 32 + fr, fq * 8);
#define PG8_SA(b, h) (((b) * 2 + (h)) * HTB)
#define PG8_SB(b, h) ((4 + (b) * 2 + (h)) * HTB)
#define PG8_STAGE(bufoff, gbase, voff) do { _Pragma("unroll") for (int _i = 0; _i < 2; ++_i) \
        __builtin_amdgcn_global_load_lds((const unsigned*)((const char*)(gbase) + (voff)[_i]), (LAS unsigned*)(lds + (bufoff) + ldsw + _i * 8192), 16, 0, 0); } while (0)
#define PG8_LDA(dst, b, h) do { _Pragma("unroll") for (int m = 0; m < 4; ++m) _Pragma("unroll") for (int k = 0; k < 2; ++k) dst[m][k] = *(const LAS bf16x8*)(lds + PG8_SA(b, h) + aoff + m * 2048 + k * 1024); } while (0)
#define PG8_LDB(dst, b, h) do { _Pragma("unroll") for (int n = 0; n < 2; ++n) _Pragma("unroll") for (int k = 0; k < 2; ++k) dst[n][k] = *(const LAS bf16x8*)(lds + PG8_SB(b, h) + boff + n * 2048 + k * 1024); } while (0)
#define PG8_MMA(ai, bj, At, Bt) do { __builtin_amdgcn_s_setprio(1); _Pragma("unroll") for (int m = 0; m < 4; ++m) _Pragma("unroll") for (int n = 0; n < 2; ++n) _Pragma("unroll") for (int k = 0; k < 2; ++k) \
        acc[ai][bj][m][n] = __builtin_amdgcn_mfma_f32_16x16x32_bf16(Bt[n][k], At[m][k], acc[ai][bj][m][n], 0, 0, 0); __builtin_amdgcn_s_setprio(0); } while (0)
#define PG8_WAIT_V(n) asm volatile("s_waitcnt vmcnt(" #n ")" ::: "memory")
#define PG8_WAIT_L(n) asm volatile("s_waitcnt lgkmcnt(" #n ")" ::: "memory")
#define PG8_BAR __builtin_amdgcn_s_barrier()
#define PG8_SCHED __builtin_amdgcn_sched_barrier(0)
    Unit cur, nxt; int ui = 0;
    if (!S.next(0, cur)) return;
    f32x4 acc[2][2][4][2];
#pragma unroll
    for (int a = 0; a < 2; ++a)
#pragma unroll
        for (int b = 0; b < 2; ++b)
#pragma unroll
            for (int m = 0; m < 4; ++m)
#pragma unroll
                for (int n = 0; n < 2; ++n) acc[a][b][m][n] = (f32x4){0.f, 0.f, 0.f, 0.f};
    bf16x8 At[4][2], B0[2][2], B1[2][2];
#define PG8_AROW(u_) ((size_t)((u_).pm * BM + g.a_base + ((u_).pm >> 4) * g.a_skip) * (size_t)(g.lda * 2) + (size_t)(u_).pn * g.a_pn_bytes + (size_t)(u_).koff)
    const char* cA = (const char*)g.A + PG8_AROW(cur); const char* cB = (const char*)g.Bt + (size_t)cur.pn * tB + (size_t)cur.koff;
    PG8_STAGE(PG8_SB(0, 0), cB, voffB); PG8_STAGE(PG8_SB(0, 1), cB + hB, voffB); PG8_STAGE(PG8_SA(0, 0), cA, voffA); PG8_STAGE(PG8_SA(0, 1), cA + hA, voffA);
    if (wr == 1) PG8_BAR;
    PG8_WAIT_V(2); PG8_BAR;
    PG8_STAGE(PG8_SB(1, 0), cB + kstep, voffB); PG8_STAGE(PG8_SA(1, 0), cA + kstep, voffA); PG8_STAGE(PG8_SB(1, 1), cB + hB + kstep, voffB);
    PG8_WAIT_V(6); PG8_BAR;
    for (;;) {
        const bool has_next = S.next(ui + 1, nxt);
        const char* nA = has_next ? (const char*)g.A + PG8_AROW(nxt) : cA; const char* nB = has_next ? (const char*)g.Bt + (size_t)nxt.pn * tB + (size_t)nxt.koff : cB;
        for (int t = 0; t < nt; t += 2) {
            const bool last = (t == nt - 2);
            const char* a1 = cA + (size_t)(t + 1) * kstep;
            const char* a2 = last ? nA : cA + (size_t)(t + 2) * kstep; const char* b2 = last ? nB : cB + (size_t)(t + 2) * kstep;
            const char* a3 = a2 + kstep; const char* b3 = b2 + kstep;
            PG8_LDB(B0, 0, 0); PG8_LDB(B1, 0, 1); PG8_SCHED; PG8_LDA(At, 0, 0); PG8_STAGE(PG8_SA(1, 1), a1 + hA, voffA);
            PG8_WAIT_V(8); PG8_WAIT_L(0); PG8_BAR; PG8_MMA(0, 0, At, B0); PG8_MMA(0, 1, At, B1); PG8_BAR; PG8_SCHED;
            PG8_LDA(At, 0, 1); PG8_STAGE(PG8_SB(0, 0), b2, voffB); PG8_STAGE(PG8_SB(0, 1), b2 + hB, voffB); PG8_STAGE(PG8_SA(0, 0), a2, voffA);
            PG8_WAIT_V(8); PG8_WAIT_L(0); PG8_BAR; PG8_MMA(1, 0, At, B0); PG8_MMA(1, 1, At, B1); PG8_BAR; PG8_SCHED;
            PG8_LDB(B0, 1, 0); PG8_LDB(B1, 1, 1); PG8_SCHED; PG8_LDA(At, 1, 0); PG8_STAGE(PG8_SA(0, 1), a2 + hA, voffA);
            PG8_WAIT_V(8); PG8_WAIT_L(0); PG8_BAR; PG8_MMA(0, 0, At, B0); PG8_MMA(0, 1, At, B1); PG8_BAR; PG8_SCHED;
            PG8_LDA(At, 1, 1); PG8_STAGE(PG8_SB(1, 0), b3, voffB); PG8_STAGE(PG8_SB(1, 1), b3 + hB, voffB); PG8_STAGE(PG8_SA(1, 0), a3, voffA);
            PG8_WAIT_V(8); PG8_WAIT_L(0); PG8_BAR; PG8_MMA(1, 0, At, B0); PG8_MMA(1, 1, At, B1); PG8_BAR; PG8_SCHED;
        }
        if constexpr (ALIGN_EPI) { if (wr == 0) PG8_BAR; }
        E(acc, cur, wr, wc, fr, fq);
        if (!has_next) break;
#pragma unroll
        for (int a = 0; a < 2; ++a)
#pragma unroll
            for (int b = 0; b < 2; ++b)
#pragma unroll
                for (int m = 0; m < 4; ++m)
#pragma unroll
                    for (int n = 0; n < 2; ++n) acc[a][b][m][n] = (f32x4){0.f, 0.f, 0.f, 0.f};
        cur = nxt; cA = nA; cB = nB; ++ui;
        if constexpr (ALIGN_EPI) { if (wr == 1) PG8_BAR; }
    }
    PG8_WAIT_V(0);
    if constexpr (!ALIGN_EPI) { if (wr == 0) PG8_BAR; }
    PG8_BAR;
#undef PG8_AROW
#undef PG8_SA
#undef PG8_SB
#undef PG8_STAGE
#undef PG8_LDA
#undef PG8_LDB
#undef PG8_MMA
#undef PG8_WAIT_V
#undef PG8_WAIT_L
#undef PG8_BAR
#undef PG8_SCHED
}

__device__ __forceinline__ unsigned cvt_pk_bf16(float lo, float hi) { f32x2 v = {lo, hi}; bf16x2_t b = __builtin_convertvector(v, bf16x2_t); return __builtin_bit_cast(unsigned, b); }
__device__ __forceinline__ float silu_f(float x) { return x * __builtin_amdgcn_rcpf(1.0f + __builtin_amdgcn_exp2f(-LOG2E * x)); }

struct EpiSwiGLU {
    bf16_t* O;
    __device__ __forceinline__ void operator()(const f32x4 (&acc)[2][2][4][2], const Unit& u, int wr, int wc, int fr, int fq) const {
        const int row0 = u.pm * BM + wr * 64 + fr, col0 = u.pn * 128 + wc * 32 + 8 * fq;
#pragma unroll
        for (int ai = 0; ai < 2; ++ai)
#pragma unroll
            for (int m = 0; m < 4; ++m) {
                bf16_t* rowp = O + (size_t)(row0 + ai * HALF + m * 16) * DFF + col0;
                const f32x4 g0 = acc[ai][0][m][0], g1 = acc[ai][0][m][1], u0 = acc[ai][1][m][0], u1 = acc[ai][1][m][1];
                u32x4 w;
                w.x = cvt_pk_bf16(silu_f(g0[0]) * u0[0], silu_f(g0[1]) * u0[1]); w.y = cvt_pk_bf16(silu_f(g0[2]) * u0[2], silu_f(g0[3]) * u0[3]);
                w.z = cvt_pk_bf16(silu_f(g1[0]) * u1[0], silu_f(g1[1]) * u1[1]); w.w = cvt_pk_bf16(silu_f(g1[2]) * u1[2], silu_f(g1[3]) * u1[3]);
                *(u32x4*)rowp = w;
                asm volatile("" ::: "memory");
            }
    }
};
struct EpiResid {
    float* H; int r_base, r_skip;
    __device__ __forceinline__ void operator()(const f32x4 (&acc)[2][2][4][2], const Unit& u, int wr, int wc, int fr, int fq) const {
        const int row0 = u.pm * BM + r_base + (u.pm >> 4) * r_skip + wr * 64 + fr, col0 = u.pn * BM + wc * 32 + 8 * fq;
#pragma unroll
        for (int ai = 0; ai < 2; ++ai)
#pragma unroll
            for (int m = 0; m < 4; ++m) {
                const int row = row0 + ai * HALF + m * 16;
                if (row < M) {
                    float* rowp = H + (size_t)row * D + col0;
#pragma unroll
                    for (int bj = 0; bj < 2; ++bj)
#pragma unroll
                        for (int n = 0; n < 2; ++n) { f32x4* p = (f32x4*)(rowp + bj * HALF + 4 * n); const f32x4 v = *p; *p = v * ALPHA + acc[ai][bj][m][n]; }
                }
            }
    }
};
struct EpiPartial {
    float* P; int kchunk2;
    __device__ __forceinline__ void operator()(const f32x4 (&acc)[2][2][4][2], const Unit& u, int wr, int wc, int fr, int fq) const {
        const int kc = u.koff / kchunk2; const int col0 = u.pn * BM + wc * 32 + 8 * fq;
        float* base = P + ((size_t)kc * HALF + wr * 64 + fr) * D + col0;
#pragma unroll
        for (int m = 0; m < 4; ++m)
#pragma unroll
            for (int bj = 0; bj < 2; ++bj)
#pragma unroll
                for (int n = 0; n < 2; ++n) *(f32x4*)(base + (size_t)(m * 16) * D + bj * HALF + 4 * n) = acc[0][bj][m][n];
    }
};
struct EpiPool {
    const float* x; const float* meta; const float* scale; float* H;
    __device__ __forceinline__ void operator()(const f32x4 (&acc)[2][2][4][2], const Unit& u, int wr, int wc, int fr, int fq) const {
        const int row0 = u.pm * BM + wr * 64 + fr, col0 = u.pn * BM + wc * 32 + 8 * fq;
        const int blo = (u.pm * BM) / LSEQ, bound = (blo + 1) * LSEQ;
#pragma unroll
        for (int ai = 0; ai < 2; ++ai)
#pragma unroll
            for (int m = 0; m < 4; ++m) {
                const int row = row0 + ai * HALF + m * 16;
                if (row < M) {
                    const int b = blo + (row >= bound ? 1 : 0), p = row - b * LSEQ;
                    const float* src = (p < NMETA ? meta + (size_t)p * D : x + (size_t)(row - NMETA * (b + 1)) * D) + col0;
                    float* rowp = H + (size_t)row * D + col0;
#pragma unroll
                    for (int bj = 0; bj < 2; ++bj)
#pragma unroll
                        for (int n = 0; n < 2; ++n) { const f32x4 v = *(const f32x4*)(src + bj * HALF + 4 * n); const f32x4 sc = *(const f32x4*)(scale + col0 + bj * HALF + 4 * n);
                            *(f32x4*)(rowp + bj * HALF + 4 * n) = v * ALPHA + acc[ai][bj][m][n] * sc; }
                }
                asm volatile("" ::: "memory");
            }
    }
};
struct EpiQKV {
    bf16_t* QKV; float* LF;
    __device__ __forceinline__ void operator()(const f32x4 (&acc)[2][2][4][2], const Unit& u, int wr, int wc, int fr, int fq) const {
        const int row0 = u.pm * BM + wr * 64 + fr; const int t = u.pn >> 2;
        const int blo = (u.pm * BM) / LSEQ, bound = (blo + 1) * LSEQ;
        if (t < 3) {
            bf16_t* base = QKV + (size_t)t * ((WS_K - WS_Q) / 2); const float sc = (t == 0) ? QSCALE : 1.0f;
            const int col0 = (u.pn & 3) * BM + wc * 32 + 8 * fq;
#pragma unroll
            for (int ai = 0; ai < 2; ++ai)
#pragma unroll
                for (int m = 0; m < 4; ++m) {
                    const int row = row0 + ai * HALF + m * 16;
                    if (row < M) {
                        const int prow = row + PADF * (blo + 1) + (row >= bound ? PADF : 0);
                        bf16_t* rowp = base + (size_t)prow * D + col0;
#pragma unroll
                        for (int bj = 0; bj < 2; ++bj) { const f32x4 v0 = acc[ai][bj][m][0] * sc, v1 = acc[ai][bj][m][1] * sc;
                            u32x4 w; w.x = cvt_pk_bf16(v0[0], v0[1]); w.y = cvt_pk_bf16(v0[2], v0[3]); w.z = cvt_pk_bf16(v1[0], v1[1]); w.w = cvt_pk_bf16(v1[2], v1[3]);
                            *(u32x4*)(rowp + bj * HALF) = w; }
                    }
                    asm volatile("" ::: "memory");
                }
        } else if (wc == 0 && fq < 2) {
#pragma unroll
            for (int ai = 0; ai < 2; ++ai)
#pragma unroll
                for (int m = 0; m < 4; ++m) {
                    const int row = row0 + ai * HALF + m * 16;
                    if (row < M) {
#pragma unroll
                        for (int n = 0; n < 2; ++n) *(f32x4*)(LF + (size_t)row * 16 + 8 * fq + 4 * n) = acc[ai][0][m][n];
                    }
                }
        }
    }
};
}

__device__ __forceinline__ float wave_sum(float v) {
#pragma unroll
    for (int o = 1; o < 64; o <<= 1) v += __shfl_xor(v, o);
    return v;
}
__device__ __forceinline__ unsigned pk2(float lo, float hi) { return pg8::cvt_pk_bf16(lo, hi); }

__device__ __forceinline__ void transpose_item(const float* W, int ldw, int k0, int n0, int n_valid, bf16_t* WT, int ldwt, int dst_row0, LAS float* scr, int lane) {
#pragma unroll 8
    for (int i = 0; i < 32; ++i) { const int kk = 2 * i + (lane >> 5); const int n = n0 + (lane & 31); scr[kk * 33 + (lane & 31)] = (n < n_valid) ? W[(size_t)(k0 + kk) * ldw + n] : 0.f; }
    asm volatile("s_waitcnt lgkmcnt(0)" ::: "memory");
    const int c = lane & 7;
#pragma unroll
    for (int j = 0; j < 4; ++j) { const int n = (lane >> 3) + 8 * j; const LAS float* s = scr + (8 * c) * 33 + n;
        u32x4 o; o.x = pk2(s[0 * 33], s[1 * 33]); o.y = pk2(s[2 * 33], s[3 * 33]); o.z = pk2(s[4 * 33], s[5 * 33]); o.w = pk2(s[6 * 33], s[7 * 33]);
        *(u32x4*)(WT + (size_t)(dst_row0 + n) * ldwt + k0 + 8 * c) = o; }
    asm volatile("s_waitcnt lgkmcnt(0)" ::: "memory");
}

struct Args {
    const float* x; const float* meta; const float* pool_w; const float* pool_scale; const float* w_in; const float* b_f; const float* w_o;
    const float* w_gate; const float* w_up; const float* w_down; const float* ln_g; const float* ln_b;
    float* out; unsigned char* ws;
};

__device__ __forceinline__ void phase_prologue(const Args& a, LAS unsigned char* lds, int gw, int NGW, int wave, int lane) {
    unsigned char* ws = a.ws;
    LAS float* scr = (LAS float*)(lds + wave * 16384);
    constexpr int I_POOL = 4 * 4 * 8;
    constexpr int I_GU = 16 * 88;
    constexpr int I_DN = 44 * 32;
    constexpr int I_IN = 16 * 104;
    constexpr int I_O = 16 * 32;
    constexpr int NITEMS = I_POOL + 4 * I_GU + 2 * I_DN + I_IN + I_O;
    for (int it = gw; it < NITEMS; it += NGW) {
        int r = it;
        if (r < I_POOL) { const int g = r / 32, rr = r % 32, kb = rr / 8, nb = rr % 8;
            transpose_item(a.pool_w + (size_t)g * 65536, 256, 64 * kb, 32 * nb, 256, (bf16_t*)(ws + WS_WPOOL), 256, g * 256 + 32 * nb, scr, lane); continue; }
        r -= I_POOL;
        if (r < 4 * I_GU) { const int which = r / I_GU, rr = r % I_GU, layer = which >> 1, up = which & 1, kb = rr / 88, nb = rr % 88, n0 = 32 * nb;
            const float* W = (up ? a.w_up : a.w_gate) + (size_t)layer * D * DFF;
            bf16_t* WT = (bf16_t*)(ws + (layer ? WS_WGU1 : WS_WGU0));
            transpose_item(W, DFF, 64 * kb, n0, DFF, WT, D, (n0 / 128) * 256 + up * 128 + (n0 % 128), scr, lane); continue; }
        r -= 4 * I_GU;
        if (r < 2 * I_DN) { const int layer = r / I_DN, rr = r % I_DN, kb = rr / 32, nb = rr % 32;
            transpose_item(a.w_down + (size_t)layer * DFF * D, D, 64 * kb, 32 * nb, D, (bf16_t*)(ws + (layer ? WS_WD1 : WS_WD0)), DFF, 32 * nb, scr, lane); continue; }
        r -= 2 * I_DN;
        if (r < I_IN) { const int kb = r / 104, nb = r % 104;
            transpose_item(a.w_in, 3 * D + NH, 64 * kb, 32 * nb, 3 * D + NH, (bf16_t*)(ws + WS_WIN), D, 32 * nb, scr, lane); continue; }
        r -= I_IN;
        { const int kb = r / 32, nb = r % 32; transpose_item(a.w_o, D, 64 * kb, 32 * nb, D, (bf16_t*)(ws + WS_WO), D, 32 * nb, scr, lane); }
    }
    bf16_t* Y = (bf16_t*)(ws + WS_ACT);
    constexpr int CH_PER_B = LSEQ / 16;
    for (int ck = gw; ck < BATCH * CH_PER_B; ck += NGW) {
        const int b = ck / CH_PER_B, r0 = (ck % CH_PER_B) * 16;
        f32x4 S[4];
#pragma unroll
        for (int g = 0; g < 4; ++g) S[g] = (f32x4){0.f, 0.f, 0.f, 0.f};
#define H0ROW(p) (((p) < NMETA) ? a.meta + (size_t)(p) * D : a.x + ((size_t)b * SEQ + ((p) - NMETA)) * D)
#pragma unroll
        for (int g = 0; g < 4; ++g) { const int w = 2 << g;
            for (int s = r0 - w + 1; s < r0; ++s) if (s >= 0) S[g] += *(const f32x4*)(H0ROW(s) + g * 256 + lane * 4); }
        for (int p = r0; p < r0 + 16; ++p) {
            const float* cur = H0ROW(p);
#pragma unroll
            for (int g = 0; g < 4; ++g) { const int w = 2 << g;
                const f32x4 xv = *(const f32x4*)(cur + g * 256 + lane * 4);
                S[g] += xv;
                const int cnt = (p + 1 < w) ? (p + 1) : w;
                const f32x4 y = S[g] * (1.0f / (float)cnt) - xv;
                u32x2 o; o.x = pk2(y[0], y[1]); o.y = pk2(y[2], y[3]);
                *(u32x2*)(Y + (size_t)(b * LSEQ + p) * D + g * 256 + lane * 4) = o;
                const int sub = p - w + 1;
                if (sub >= 0) S[g] -= *(const f32x4*)(H0ROW(sub) + g * 256 + lane * 4);
            }
        }
#undef H0ROW
    }
}

template <bool FINAL, bool TAILP>
__device__ __forceinline__ void phase_ln(const Args& a, const float* g, const float* bta, int gw, int NGW, int lane) {
    float* H = (float*)(a.ws + WS_H); bf16_t* HB = (bf16_t*)(a.ws + WS_HB);
    f32x4 gv[4], bv[4];
#pragma unroll
    for (int j = 0; j < 4; ++j) { gv[j] = *((const f32x4*)g + lane + 64 * j); bv[j] = *((const f32x4*)bta + lane + 64 * j); }
    for (int m = gw; m < M; m += NGW) {
        f32x4* xr = (f32x4*)(H + (size_t)m * D) + lane;
        f32x4 v[4]; float s = 0.f;
#pragma unroll
        for (int j = 0; j < 4; ++j) v[j] = xr[64 * j];
        if (TAILP && m >= 32768) {
            const f32x4* pp = (const f32x4*)((const float*)(a.ws + WS_P) + (size_t)(m - 32768) * D) + lane;
#pragma unroll
            for (int j = 0; j < 4; ++j) { f32x4 t = v[j] * ALPHA;
                for (int kc = 0; kc < 11; ++kc) t += pp[(size_t)kc * (128 * D / 4) + 64 * j];
                v[j] = t; }
        }
#pragma unroll
        for (int j = 0; j < 4; ++j) s += (v[j].x + v[j].y) + (v[j].z + v[j].w);
        const float mean = wave_sum(s) * (1.f / D); float s2 = 0.f;
#pragma unroll
        for (int j = 0; j < 4; ++j) { v[j] = v[j] - mean; s2 += (v[j].x * v[j].x + v[j].y * v[j].y) + (v[j].z * v[j].z + v[j].w * v[j].w); }
        const float rstd = 1.f / sqrtf(wave_sum(s2) * (1.f / D) + LN_EPS);
        if (FINAL) {
            const int b = m / LSEQ, p = m - b * LSEQ;
            if (p >= NMETA) { f32x4* o = (f32x4*)(a.out + ((size_t)b * SEQ + (p - NMETA)) * D) + lane;
#pragma unroll
                for (int j = 0; j < 4; ++j) o[64 * j] = v[j] * rstd * gv[j] + bv[j]; }
        } else {
            u32x2* o8 = (u32x2*)(HB + (size_t)m * D) + lane;
#pragma unroll
            for (int j = 0; j < 4; ++j) { const f32x4 y = v[j] * rstd * gv[j] + bv[j]; xr[64 * j] = y; u32x2 w; w.x = pk2(y.x, y.y); w.y = pk2(y.z, y.w); o8[64 * j] = w; }
        }
    }
}

__device__ __forceinline__ float log2_sigmoid(float xx) { return -LOG2E * (fmaxf(-xx, 0.f) + log1pf(__expf(-fabsf(xx)))); }
__device__ __forceinline__ void phase_cumsum(const Args& a, int gw, int NGW, int lane) {
    const float* LF = (const float*)(a.ws + WS_LF); float* C2 = (float*)(a.ws + WS_C2);
    for (int bh = gw; bh < BATCH * NH; bh += NGW) {
        const int b = bh >> 4, h = bh & 15;
        const float bias = a.b_f[h];
        const int p0 = lane * 65; const int p1 = (p0 + 65 < LSEQ) ? p0 + 65 : LSEQ;
        float sum = 0.f;
        for (int p = p0; p < p1; ++p) sum += log2_sigmoid(LF[(size_t)(b * LSEQ + p) * 16 + h] + bias);
        float incl = sum;
#pragma unroll
        for (int off = 1; off < 64; off <<= 1) { const float t = __shfl_up(incl, off); if (lane >= off) incl += t; }
        float run = incl - sum;
        for (int p = p0; p < p1; ++p) { run += log2_sigmoid(LF[(size_t)(b * LSEQ + p) * 16 + h] + bias); C2[(size_t)bh * LPAD + PADF + p] = run; }
        for (int i = lane; i < PADF; i += 64) C2[(size_t)bh * LPAD + i] = 0.f;
    }
    { unsigned* KMAX = (unsigned*)(a.ws + WS_CTL) + 256; const bf16_t* Kb = (const bf16_t*)(a.ws + WS_K);
      for (int it = gw; it < BATCH * NH * 65; it += NGW) {
          const int bh = it / 65, t = 3 + it % 65, b = bh >> 4, h = bh & 15; const int pp = t * 64 + lane;
          float n2 = 0.f;
          if (pp >= PADF) { const u32x4* kp = (const u32x4*)(Kb + ((size_t)b * LPAD + pp) * D + h * HD);
#pragma unroll
              for (int c = 0; c < 8; ++c) { const u32x4 w = kp[c];
#pragma unroll
                  for (int j = 0; j < 4; ++j) { const float lo = __uint_as_float(w[j] << 16), hi = __uint_as_float(w[j] & 0xffff0000u); n2 += lo * lo + hi * hi; } } }
#pragma unroll
          for (int o = 1; o < 64; o <<= 1) n2 = fmaxf(n2, __shfl_xor(n2, o));
          if (lane == 0) atomicMax(KMAX + bh, __float_as_uint(sqrtf(n2)));
      } }
    for (int r = gw; r < 3 * BATCH * PADF; r += NGW) {
        const int t = r / (BATCH * PADF), rr = r % (BATCH * PADF), b = rr / PADF, pp = rr % PADF;
        bf16_t* base = (bf16_t*)(a.ws + (t == 0 ? WS_Q : t == 1 ? WS_K : WS_V)) + (size_t)(b * LPAD + pp) * D;
        u32x4 z = {0u, 0u, 0u, 0u};
        *((u32x4*)base + lane) = z; *((u32x4*)base + 64 + lane) = z;
    }
}

namespace att {
constexpr int RSK = 144, RSV = 192, KBUF = 64 * RSK, VBUF = 64 * RSV;
constexpr int OFF_K = 0, OFF_V = 2 * KBUF, OFF_C = OFF_V + 2 * VBUF, OFF_W = OFF_C + 2 * 256, TOTAL = OFF_W + 8 * 256;
static_assert(TOTAL <= 131072, "attention LDS");
constexpr int NQB = LPAD / 256;
constexpr int NUNITS = BATCH * NH * NQB;
__device__ __forceinline__ int crow(int r, int hi) { return (r & 3) + 8 * (r >> 2) + 4 * hi; }

__device__ __forceinline__ void attn_unit(int bh, int qb, const bf16_t* Q, const bf16_t* K, const bf16_t* V, bf16_t* O, const float* C2, const unsigned* KMAXp, LAS unsigned char* lds, const int wid) {
    const int lane = lane_id_asm(), tid = wid * 64 + lane, r32 = lane & 31, hi = lane >> 5;
    const int b = bh >> 4, h = bh & 15;
    const size_t rowbase = (size_t)b * LPAD;
    const int qw0 = qb * 256 + wid * 32, myq = qw0 + r32;
    bf16x8 qr[4];
    { const bf16_t* Qp = Q + (rowbase + myq) * D + h * HD;
#pragma unroll
      for (int d0 = 0; d0 < 4; ++d0) qr[d0] = *(const bf16x8*)(Qp + d0 * 16 + hi * 8); }
    const float cq = C2[(size_t)bh * LPAD + myq];
    float m_run = NEGBIG, l_run = 0.f;
    f32x16 o[2];
#pragma unroll
    for (int r = 0; r < 16; ++r) { o[0][r] = 0.f; o[1][r] = 0.f; }
    const int thi = 4 * qb + 3;
    int t_lo;
    { float qn2 = 0.f;
#pragma unroll
      for (int d0 = 0; d0 < 4; ++d0)
#pragma unroll
          for (int j = 0; j < 8; ++j) { const float v = __uint_as_float(((unsigned)(unsigned short)qr[d0][j]) << 16); qn2 += v * v; }
      qn2 += __shfl_xor(qn2, 32);
#pragma unroll
      for (int o = 1; o < 32; o <<= 1) qn2 = fmaxf(qn2, __shfl_xor(qn2, o));
      LAS float* qsh = (LAS float*)(lds + OFF_W);
      if (lane == 0) qsh[wid * 64] = qn2;
      __syncthreads();
      float qm = qsh[0];
#pragma unroll
      for (int w = 1; w < 8; ++w) qm = fmaxf(qm, qsh[w * 64]);
      const float kmax = __uint_as_float(((const unsigned*)KMAXp)[bh]);
      const float X = C2[(size_t)bh * LPAD + qb * 256] + 2.02f * sqrtf(qm) * kmax + 152.0f;
      int cand = thi;
      for (int t = 3 + lane; t <= thi; t += 64) if (C2[(size_t)bh * LPAD + t * 64 + 63] <= X) cand = min(cand, t);
#pragma unroll
      for (int o = 1; o < 64; o <<= 1) cand = min(cand, __shfl_xor(cand, o));
      t_lo = __builtin_amdgcn_readfirstlane(cand);
      __syncthreads(); }
    const int srow = tid >> 3, sch = tid & 7;
    const bf16_t* gK = K + (rowbase + srow) * D + h * HD + sch * 8;
    const bf16_t* gV = V + (rowbase + srow) * D + h * HD + sch * 8;
    const float* gC = C2 + (size_t)bh * LPAD;
    LAS float* wsf = (LAS float*)(lds + OFF_W) + wid * 64;
    { const u32x4 kv = *(const u32x4*)(gK + (size_t)thi * 64 * D), vv = *(const u32x4*)(gV + (size_t)thi * 64 * D);
      *(LAS u32x4*)(lds + OFF_K + srow * RSK + sch * 16) = kv; *(LAS u32x4*)(lds + OFF_V + srow * RSV + sch * 16) = vv;
      if (tid < 64) *(LAS float*)(lds + OFF_C + tid * 4) = gC[thi * 64 + tid]; }
    __syncthreads();
    const int i16 = lane & 15, q4 = i16 >> 2, p4 = i16 & 3, blk = (lane >> 4) & 1;
    const int vtr_off = (4 * hi + q4) * RSV + (16 * blk + 4 * p4) * 2;
    int it = 0;
    for (int t = thi; t >= t_lo; --t, ++it) {
        const int buf = it & 1;
        u32x4 kvn = {0u, 0u, 0u, 0u}, vvn = {0u, 0u, 0u, 0u}; float cn = 0.f;
        if (t > t_lo) { kvn = *(const u32x4*)(gK + (size_t)(t - 1) * 64 * D); vvn = *(const u32x4*)(gV + (size_t)(t - 1) * 64 * D); if (tid < 64) cn = gC[(t - 1) * 64 + tid]; }
        const int k0 = t * 64;
        if (k0 <= qw0 + 31) {
            const LAS unsigned char* Kb = lds + OFF_K + buf * KBUF; const LAS unsigned char* Vb = lds + OFF_V + buf * VBUF;
            const LAS float* ckp = (const LAS float*)(lds + OFF_C + buf * 256);
            f32x16 p0, p1;
#pragma unroll
            for (int r = 0; r < 16; ++r) { p0[r] = 0.f; p1[r] = 0.f; }
#pragma unroll
            for (int d0 = 0; d0 < 4; ++d0) {
                const bf16x8 a0 = *(const LAS bf16x8*)(Kb + r32 * RSK + (d0 * 16 + hi * 8) * 2);
                const bf16x8 a1 = *(const LAS bf16x8*)(Kb + (32 + r32) * RSK + (d0 * 16 + hi * 8) * 2);
                p0 = __builtin_amdgcn_mfma_f32_32x32x16_bf16(a0, qr[d0], p0, 0, 0, 0);
                p1 = __builtin_amdgcn_mfma_f32_32x32x16_bf16(a1, qr[d0], p1, 0, 0, 0);
            }
#pragma unroll
            for (int g = 0; g < 4; ++g) {
                const f32x4 c0 = *(const LAS f32x4*)(ckp + 8 * g + 4 * hi), c1 = *(const LAS f32x4*)(ckp + 32 + 8 * g + 4 * hi);
#pragma unroll
                for (int j = 0; j < 4; ++j) { p0[4 * g + j] += cq - c0[j]; p1[4 * g + j] += cq - c1[j]; }
            }
            if (t == 3 || k0 + 63 > qw0) {
#pragma unroll
                for (int r = 0; r < 16; ++r) { const int kv = k0 + crow(r, hi);
                    if (kv > myq || kv < PADF) p0[r] = NEGBIG;
                    if (kv + 32 > myq || kv + 32 < PADF) p1[r] = NEGBIG; }
            }
            float mx = fmaxf(p0[0], p1[0]);
#pragma unroll
            for (int r = 1; r < 16; ++r) mx = fmaxf(mx, fmaxf(p0[r], p1[r]));
            mx = fmaxf(mx, __shfl_xor(mx, 32));
            const float m_new = fmaxf(m_run, mx);
            if (__any(m_new > m_run)) {
                const float alpha = __builtin_amdgcn_exp2f(m_run - m_new);
                l_run *= alpha;
                if (hi == 0) wsf[r32] = alpha;
                asm volatile("s_waitcnt lgkmcnt(0)" ::: "memory");
#pragma unroll
                for (int g = 0; g < 4; ++g) { const f32x4 f = *(const LAS f32x4*)(wsf + 8 * g + 4 * hi);
#pragma unroll
                    for (int j = 0; j < 4; ++j) { o[0][4 * g + j] *= f[j]; o[1][4 * g + j] *= f[j]; } }
                asm volatile("s_waitcnt lgkmcnt(0)" ::: "memory");
                m_run = m_new;
            }
            float ls = 0.f;
#pragma unroll
            for (int r = 0; r < 16; ++r) { p0[r] = __builtin_amdgcn_exp2f(p0[r] - m_run); p1[r] = __builtin_amdgcn_exp2f(p1[r] - m_run); ls += p0[r] + p1[r]; }
            l_run += ls;
            bf16x8 pa[4];
#pragma unroll
            for (int s = 0; s < 4; ++s) { u32x4 w;
#pragma unroll
                for (int j = 0; j < 4; ++j) { const int r = 8 * (s & 1) + 2 * j; w[j] = (s < 2) ? pg8::cvt_pk_bf16(p0[r], p0[r + 1]) : pg8::cvt_pk_bf16(p1[r], p1[r + 1]); }
                pa[s] = __builtin_bit_cast(bf16x8, w); }
#pragma unroll
            for (int d0 = 0; d0 < 2; ++d0)
#pragma unroll
                for (int s = 0; s < 4; ++s) {
                    const LAS unsigned char* vp = Vb + vtr_off + (16 * s) * RSV + d0 * 64;
                    const s16x4 lo = __builtin_bit_cast(s16x4, __builtin_amdgcn_ds_read_tr16_b64_v4i16((LAS s16x4*)vp));
                    const s16x4 hh = __builtin_bit_cast(s16x4, __builtin_amdgcn_ds_read_tr16_b64_v4i16((LAS s16x4*)(vp + 8 * RSV)));
                    const bf16x8 vb = __builtin_shufflevector(lo, hh, 0, 1, 2, 3, 4, 5, 6, 7);
                    o[d0] = __builtin_amdgcn_mfma_f32_32x32x16_bf16(pa[s], vb, o[d0], 0, 0, 0);
                }
        }
        if (t > t_lo) {
            const int nb = buf ^ 1;
            *(LAS u32x4*)(lds + OFF_K + nb * KBUF + srow * RSK + sch * 16) = kvn; *(LAS u32x4*)(lds + OFF_V + nb * VBUF + srow * RSV + sch * 16) = vvn;
            if (tid < 64) *(LAS float*)(lds + OFF_C + nb * 256 + tid * 4) = cn;
        }
        __syncthreads();
    }
    float l_tot = l_run + __shfl_xor(l_run, 32);
    if (hi == 0) wsf[r32] = 1.0f / l_tot;
    asm volatile("s_waitcnt lgkmcnt(0)" ::: "memory");
    bf16_t* Op = O + (rowbase + qw0) * D + h * HD + r32;
#pragma unroll
    for (int g = 0; g < 4; ++g) { const f32x4 f = *(const LAS f32x4*)(wsf + 8 * g + 4 * hi);
#pragma unroll
        for (int j = 0; j < 4; ++j) { const int r = 4 * g + j; const int qrow = crow(r, hi);
            const unsigned w0 = pg8::cvt_pk_bf16(o[0][r] * f[j], 0.f), w1 = pg8::cvt_pk_bf16(o[1][r] * f[j], 0.f);
            Op[(size_t)qrow * D] = (bf16_t)(w0 & 0xffffu); Op[(size_t)qrow * D + 32] = (bf16_t)(w1 & 0xffffu); } }
    asm volatile("s_waitcnt lgkmcnt(0)" ::: "memory");
    __syncthreads();
}
}

__global__ void __launch_bounds__(512, 2) fwd_megakernel(Args a) {
    extern __shared__ __attribute__((aligned(16))) unsigned char lds_raw[];
    LAS unsigned char* lds = (LAS unsigned char*)lds_raw;
    const int wave = __builtin_amdgcn_readfirstlane(threadIdx.x >> 6);
    const int G = gridDim.x, bx = blockIdx.x;
    const int vcu = (G % 8 == 0) ? (bx % 8) * (G / 8) + bx / 8 : bx;
    const int gw = vcu * 8 + wave, NGW = G * 8;
    unsigned char* ws = a.ws;
    float* H = (float*)(ws + WS_H); bf16_t* HB = (bf16_t*)(ws + WS_HB); bf16_t* ACT = (bf16_t*)(ws + WS_ACT);
    unsigned* barctr = (unsigned*)(ws + WS_CTL) + 64; unsigned nbar = 0;
#define LANE() lane_id_asm()
#define GSYNC() do { ++nbar; grid_bar(barctr, nbar * (unsigned)G, wave); } while (0)

    phase_prologue(a, lds, gw, NGW, wave, LANE());
    cg::this_grid().sync();
    { pg8::Gemm g{ACT, (const bf16_t*)(ws + WS_WPOOL), D, 256, 256, 512, 0, 0}; pg8::StaticOrder S; S.init(MP, D, G, bx);
      pg8::EpiPool E{a.x, a.meta, a.pool_scale, H};
      pg8::gemm_phase<pg8::EpiPool, pg8::StaticOrder, true>(lds, g, S, E, wave); }
    GSYNC();
    phase_ln<false, false>(a, a.ln_g, a.ln_b, gw, NGW, LANE());
    GSYNC();
    { pg8::Gemm g{HB, (const bf16_t*)(ws + WS_WGU0), D, D, D, 0, 0, 0}; pg8::StaticOrder S; S.init(MP, 2 * DFF, G, bx);
      pg8::EpiSwiGLU E{ACT};
      pg8::gemm_phase<pg8::EpiSwiGLU, pg8::StaticOrder, true>(lds, g, S, E, wave); }
    GSYNC();
    { pg8::Gemm g{ACT, (const bf16_t*)(ws + WS_WD0), DFF, DFF, 256, 0, 0, 0}; pg8::TailKOrder S{128, 11, 256, bx};
      pg8::EpiPartial E{(float*)(ws + WS_P), 512};
      pg8::gemm_phase<pg8::EpiPartial, pg8::TailKOrder, true>(lds, g, S, E, wave); }
    { pg8::Gemm g{ACT, (const bf16_t*)(ws + WS_WD0), DFF, DFF, DFF, 0, 0, 0}; pg8::StaticOrder S; S.init(32768, D, G, bx);
      pg8::EpiResid E{H, 0, 0};
      pg8::gemm_phase<pg8::EpiResid, pg8::StaticOrder, true>(lds, g, S, E, wave); }
    GSYNC();
    phase_ln<false, true>(a, a.ln_g + D, a.ln_b + D, gw, NGW, LANE());
    GSYNC();
    { pg8::Gemm g{HB, (const bf16_t*)(ws + WS_WIN), D, D, D, 0, 0, 0}; pg8::StaticOrder S; S.init(MP, NIN, G, bx);
      pg8::EpiQKV E{(bf16_t*)(ws + WS_Q), (float*)(ws + WS_LF)};
      pg8::gemm_phase<pg8::EpiQKV, pg8::StaticOrder, true>(lds, g, S, E, wave); }
    GSYNC();
    phase_cumsum(a, gw, NGW, LANE());
    GSYNC();
    { unsigned* ctr = (unsigned*)(ws + WS_CTL); LAS unsigned* sh = (LAS unsigned*)(lds + LDSCTL_OFF);
      for (;;) {
          if (wave == 0 && LANE() == 0) sh[0] = atomicAdd(ctr, 1u);
          __syncthreads();
          const unsigned idx = sh[0];
          __syncthreads();
          if (idx >= (unsigned)att::NUNITS) break;
          const int qb = att::NQB - 1 - (int)(idx / (BATCH * NH)), bh = (int)(idx % (BATCH * NH));
          att::attn_unit(bh, qb, (const bf16_t*)(ws + WS_Q), (const bf16_t*)(ws + WS_K), (const bf16_t*)(ws + WS_V), (bf16_t*)(ws + WS_O), (const float*)(ws + WS_C2), (const unsigned*)(ws + WS_CTL) + 256, lds, wave);
      } }
    GSYNC();
    { pg8::Gemm g{(const bf16_t*)(ws + WS_O), (const bf16_t*)(ws + WS_WO), D, D, D, 0, 256, 256}; pg8::StaticOrder S; S.init(32768, D, G, bx);
      pg8::EpiResid E{H, NMETA, NMETA};
      pg8::gemm_phase<pg8::EpiResid, pg8::StaticOrder, true>(lds, g, S, E, wave); }
    GSYNC();
    phase_ln<false, false>(a, a.ln_g + 2 * D, a.ln_b + 2 * D, gw, NGW, LANE());
    GSYNC();
    { pg8::Gemm g{HB, (const bf16_t*)(ws + WS_WGU1), D, D, D, 0, NMETA, NMETA}; pg8::StaticOrder S; S.init(32768, 2 * DFF, G, bx);
      pg8::EpiSwiGLU E{ACT};
      pg8::gemm_phase<pg8::EpiSwiGLU, pg8::StaticOrder, true>(lds, g, S, E, wave); }
    GSYNC();
    { pg8::Gemm g{ACT, (const bf16_t*)(ws + WS_WD1), DFF, DFF, DFF, 0, 0, 0}; pg8::StaticOrder S; S.init(32768, D, G, bx);
      pg8::EpiResid E{H, NMETA, NMETA};
      pg8::gemm_phase<pg8::EpiResid, pg8::StaticOrder, true>(lds, g, S, E, wave); }
    GSYNC();
    phase_ln<true, false>(a, a.ln_g + 3 * D, a.ln_b + 3 * D, gw, NGW, LANE());
}

extern "C" void kernel_launch(void* const* d_in, const int* in_sizes, int n_in, void* d_out, int out_size, void* d_ws, size_t ws_size, hipStream_t stream) {
    static int grid = 0;
    if (grid == 0) {
        if (n_in != 12 || ws_size < WS_END) { fprintf(stderr, "kernel_launch: unexpected n_in %d / ws_size %zu\n", n_in, ws_size); grid = -1; return; }
        int dev = 0, cus = 0, per_cu = 0;
        hipGetDevice(&dev);
        hipDeviceGetAttribute(&cus, hipDeviceAttributeMultiprocessorCount, dev);
        hipFuncSetAttribute((const void*)fwd_megakernel, hipFuncAttributeMaxDynamicSharedMemorySize, LDS_BYTES);
        hipOccupancyMaxActiveBlocksPerMultiprocessor(&per_cu, (const void*)fwd_megakernel, 512, LDS_BYTES);
        if (per_cu < 1) { fprintf(stderr, "kernel_launch: occupancy query says %d blocks per CU\n", per_cu); grid = -1; return; }
        grid = cus;
    }
    if (grid < 0) return;
    hipMemsetAsync((char*)d_ws + WS_CTL, 0, 4096, stream);
    Args a{};
    a.x = (const float*)d_in[0]; a.meta = (const float*)d_in[1]; a.pool_w = (const float*)d_in[2]; a.pool_scale = (const float*)d_in[3];
    a.w_in = (const float*)d_in[4]; a.b_f = (const float*)d_in[5]; a.w_o = (const float*)d_in[6];
    a.w_gate = (const float*)d_in[7]; a.w_up = (const float*)d_in[8]; a.w_down = (const float*)d_in[9]; a.ln_g = (const float*)d_in[10]; a.ln_b = (const float*)d_in[11];
    a.out = (float*)d_out; a.ws = (unsigned char*)d_ws;
    void* args[] = {&a};
    hipError_t e = hipLaunchCooperativeKernel((const void*)fwd_megakernel, dim3(grid), dim3(512), args, LDS_BYTES, stream);
    if (e != hipSuccess) fprintf(stderr, "cooperative launch failed: %s (grid %d)\n", hipGetErrorString(e), grid);
}
```
